# Optimizing an MI355X kernel written in HIP

```python
import jax, jax.numpy as jnp
from jax import lax
import numpy as np

D_MODEL = 2048
BATCH = 4
SEQ = 4096
DEPTH = 1

PLE_DIM = 256
R_HEADS = 16
R_HEAD = 64
R_WIDTH = R_HEADS * R_HEAD
DECAY_LORA = 64
AAA_LORA = 64
GATE_LORA = 160
R_GN_EPS = 64e-5
RWKV_COLS = 3 * R_WIDTH + DECAY_LORA + AAA_LORA + GATE_LORA
M_HEADS = 8
M_QK = 64
M_V = 128
M_WIDTH = M_HEADS * M_V
CONV_K = 4
CHUNK = 128
M_NORM_EPS = 1e-6
MLSTM_COLS = 2 * M_HEADS * M_QK + 2 * M_WIDTH + 2 * M_HEADS
GATE_COLS = 2 * D_MODEL
IN_COLS = RWKV_COLS + MLSTM_COLS + GATE_COLS
N_GROUPS = 4
EXPERTS_PER_GROUP = 8
N_EXPERTS = N_GROUPS * EXPERTS_PER_GROUP
TOP_K = 2
D_EXPERT = 512
MOE_BLOCK = 128
LN_EPS = 1e-5
ALPHA = (2 * DEPTH) ** 0.25
BETA = (8 * DEPTH) ** -0.25

kernel_name = 'hybrid_rwkv7_mlstm_hmoe_block'

F32 = jnp.float32


def _split(t, sizes):
    return jnp.split(t, np.cumsum(sizes)[:-1].tolist(), axis=-1)


def _layer_norm(x, w, b):
    xf = x.astype(F32)
    mu = xf.mean(-1, keepdims=True)
    var = jnp.square(xf - mu).mean(-1, keepdims=True)
    return ((xf - mu) * lax.rsqrt(var + LN_EPS) * w + b).astype(x.dtype)


def _head_norm(y, eps):
    mu = y.mean(-1, keepdims=True)
    var = jnp.square(y - mu).mean(-1, keepdims=True)
    return (y - mu) * lax.rsqrt(var + eps)


def _causal_conv(t, w, b):
    seq = t.shape[1]
    tp = jnp.pad(t, ((0, 0), (CONV_K - 1, 0), (0, 0)))
    return b + sum(w[j] * tp[:, j:j + seq] for j in range(CONV_K))


def _rwkv7_scan(r, decay, k, v, kk, a):
    bsz, _, h, n = r.shape

    def step(state, inp):
        r_t, w_t, k_t, v_t, kk_t, a_t = inp
        s_kk = jnp.einsum('bhvk,bhk->bhv', state, kk_t)
        state = (state * w_t[:, :, None, :]
                 - s_kk[..., None] * (kk_t * a_t)[:, :, None, :]
                 + v_t[..., None] * k_t[:, :, None, :])
        return state, jnp.einsum('bhvk,bhk->bhv', state, r_t)

    xs = tuple(jnp.moveaxis(t, 1, 0) for t in (r, decay, k, v, kk, a))
    _, ys = lax.scan(step, jnp.zeros((bsz, h, n, n), F32), xs)
    return jnp.moveaxis(ys, 0, 1)


def _rwkv7_mixer(z, mu, w0, w_w2, a0, w_a2, w_g2, k_k, k_a, r_k, lnx_w, lnx_b):
    bsz, seq, _ = z.shape
    z_prev = jnp.pad(z, ((0, 0), (1, 0), (0, 0)))[:, :-1]
    z = z + mu * (z_prev - z)
    r, k, v, zw, za, zg = _split(z, [R_WIDTH, R_WIDTH, R_WIDTH, DECAY_LORA, AAA_LORA, GATE_LORA])
    w = -jax.nn.softplus(-(w0 + jnp.tanh(zw) @ w_w2).astype(F32)) - 0.5
    decay = jnp.exp(-jnp.exp(w))
    a = jax.nn.sigmoid((a0 + za @ w_a2).astype(F32))
    g = jax.nn.sigmoid(zg) @ w_g2
    heads = lambda t: t.astype(F32).reshape(bsz, seq, R_HEADS, R_HEAD)
    r, k, v, decay, a = heads(r), heads(k), heads(v), heads(decay), heads(a)
    kk = k * k_k.astype(F32).reshape(R_HEADS, R_HEAD)
    kk = kk / jnp.maximum(jnp.sqrt(jnp.sum(kk * kk, -1, keepdims=True)), 1e-12)
    k = k * (1.0 + (a - 1.0) * k_a.astype(F32).reshape(R_HEADS, R_HEAD))
    y = _rwkv7_scan(r, decay, k, v, kk, a)
    y = _head_norm(y, R_GN_EPS).reshape(bsz, seq, R_WIDTH) * lnx_w + lnx_b
    bonus = (jnp.sum(r * k * r_k.astype(F32), -1, keepdims=True) * v).reshape(bsz, seq, R_WIDTH)
    return ((y + bonus) * g).astype(z.dtype)


def _mlstm_chunkwise(q, k, v, i_pre, log_f):
    bsz, h, seq, dqk = q.shape
    dv = v.shape[-1]
    nc = seq // CHUNK

    def chunks(t):
        return jnp.moveaxis(t.reshape(t.shape[:2] + (nc, CHUNK) + t.shape[3:]), 2, 0)

    causal = jnp.tril(jnp.ones((CHUNK, CHUNK), bool))

    def step(carry, inp):
        c_st, n_st, m_st = carry
        q_c, k_c, v_c, i_c, f_c = inp
        a = jnp.cumsum(f_c, -1)
        a_tot = a[..., -1]
        d = jnp.where(causal, a[..., :, None] - a[..., None, :] + i_c[..., None, :], -jnp.inf)
        inter = a + m_st[..., None]
        m_t = jnp.maximum(inter, d.max(-1))
        s = jnp.einsum('bhtd,bhsd->bhts', q_c, k_c) * jnp.exp(d - m_t[..., None])
        ie = jnp.exp(inter - m_t)
        num = (ie[..., None] * jnp.einsum('bhtd,bhde->bhte', q_c, c_st)
               + jnp.einsum('bhts,bhse->bhte', s, v_c))
        den = ie * jnp.einsum('bhtd,bhd->bht', q_c, n_st) + s.sum(-1)
        h_c = num / jnp.maximum(jnp.abs(den), jnp.exp(-m_t))[..., None]
        gl = a_tot[..., None] - a + i_c
        m_new = jnp.maximum(a_tot + m_st, gl.max(-1))
        sc = jnp.exp(a_tot + m_st - m_new)
        ge = jnp.exp(gl - m_new[..., None])
        c_st = sc[..., None, None] * c_st + jnp.einsum('bhs,bhsd,bhse->bhde', ge, k_c, v_c)
        n_st = sc[..., None] * n_st + jnp.einsum('bhs,bhsd->bhd', ge, k_c)
        return (c_st, n_st, m_new), h_c

    init = (jnp.zeros((bsz, h, dqk, dv), F32), jnp.zeros((bsz, h, dqk), F32),
            jnp.full((bsz, h), -jnp.inf, F32))
    _, hs = lax.scan(step, init, tuple(chunks(t) for t in (q, k, v, i_pre, log_f)))
    return jnp.moveaxis(hs, 0, 2).reshape(bsz, h, seq, dv)


def _mlstm_mixer(z, conv_w, conv_b, i_bias, f_bias, mh_w):
    bsz, seq, _ = z.shape
    qk, v, ig, fg, o = _split(z, [2 * M_HEADS * M_QK, M_WIDTH, M_HEADS, M_HEADS, M_WIDTH])
    qk = jax.nn.silu(_causal_conv(qk, conv_w, conv_b))
    q, k = _split(qk, [M_HEADS * M_QK, M_HEADS * M_QK])
    heads = lambda t, d: t.astype(F32).reshape(bsz, seq, M_HEADS, d).transpose(0, 2, 1, 3)
    q, k, v = heads(q, M_QK), heads(k, M_QK) * M_QK ** -0.5, heads(v, M_V)
    i_pre = (ig + i_bias).astype(F32).transpose(0, 2, 1)
    log_f = jax.nn.log_sigmoid((fg + f_bias).astype(F32)).transpose(0, 2, 1)
    h = _mlstm_chunkwise(q, k, v, i_pre, log_f)
    h = _head_norm(h, M_NORM_EPS).transpose(0, 2, 1, 3).reshape(bsz, seq, M_WIDTH) * mh_w
    return (jax.nn.sigmoid(o) * h).astype(z.dtype)


def _hier_moe(xf, w_rg, b_rg, w_re, b_re, w_gate, w_up, w_down):
    n, d = xf.shape
    lg = (xf @ w_rg).astype(F32) + b_rg
    g_sel = jnp.argmax(lg, -1)
    g_w = jnp.take_along_axis(jax.nn.softmax(lg, -1), g_sel[:, None], -1)
    le = ((xf @ w_re).astype(F32) + b_re).reshape(n, N_GROUPS, EXPERTS_PER_GROUP)
    le = jnp.take_along_axis(le, g_sel[:, None, None], 1)[:, 0]
    top_l, top_i = lax.top_k(le, TOP_K)
    wts = jax.nn.softmax(top_l, -1) * g_w
    eid = (g_sel[:, None] * EXPERTS_PER_GROUP + top_i).reshape(-1)
    tok = jnp.repeat(jnp.arange(n, dtype=jnp.int32), TOP_K)
    wt = wts.reshape(-1)
    order = jnp.argsort(eid)
    eid_s, tok_s, wt_s = eid[order], tok[order], wt[order]
    counts = jnp.bincount(eid, length=N_EXPERTS)
    start = jnp.cumsum(counts) - counts
    padded = ((counts + MOE_BLOCK - 1) // MOE_BLOCK) * MOE_BLOCK
    pend = jnp.cumsum(padded)
    pstart = pend - padded
    n_rows = TOP_K * n
    dest = pstart[eid_s] + (jnp.arange(n_rows) - start[eid_s])
    nb = -(-n_rows // MOE_BLOCK) + N_EXPERTS
    rows = nb * MOE_BLOCK
    tok_rows = jnp.zeros((rows,), jnp.int32).at[dest].set(tok_s)
    wt_rows = jnp.zeros((rows,), F32).at[dest].set(wt_s)
    blk_e = jnp.minimum(jnp.searchsorted(pend, jnp.arange(nb) * MOE_BLOCK, side='right'),
                        N_EXPERTS - 1)

    def one_block(args):
        t_idx, e = args
        xb = xf[t_idx]
        hb = jax.nn.silu(xb @ w_gate[e]) * (xb @ w_up[e])
        return hb @ w_down[e]

    out = lax.map(one_block, (tok_rows.reshape(nb, MOE_BLOCK), blk_e)).reshape(rows, d)
    out = out * wt_rows[:, None].astype(out.dtype)
    return jnp.zeros_like(xf).at[tok_rows].add(out)


def setup_inputs(seed: int = 0) -> dict:
    key = jax.random.key(seed)
    ks = iter(jax.random.split(key, 40))
    nrm = lambda shape, s: s * jax.random.normal(next(ks), shape, F32)
    uni = lambda shape, lo, hi: jax.random.uniform(next(ks), shape, F32, lo, hi)
    L, D = DEPTH, D_MODEL
    col_scale = jnp.concatenate([
        jnp.ones((2 * R_WIDTH,), F32), jnp.full((R_WIDTH,), BETA, F32),
        jnp.ones((RWKV_COLS - 3 * R_WIDTH + 2 * M_HEADS * M_QK,), F32),
        jnp.full((M_WIDTH,), BETA, F32),
        jnp.ones((2 * M_HEADS + M_WIDTH + GATE_COLS,), F32)])
    return {
        'x': nrm((BATCH, SEQ, D), 1.0),
        'p': nrm((L, BATCH, SEQ, PLE_DIM), 1.0),
        'w_in': nrm((L, D, IN_COLS), D ** -0.5) * col_scale,
        'mu_shift': uni((L, RWKV_COLS), 0.0, 1.0),
        'w0': uni((L, R_WIDTH), -6.0, -1.0),
        'w_w2': nrm((L, DECAY_LORA, R_WIDTH), 0.5 * DECAY_LORA ** -0.5),
        'a0': nrm((L, R_WIDTH), 0.1),
        'w_a2': nrm((L, AAA_LORA, R_WIDTH), 0.5 * AAA_LORA ** -0.5),
        'w_g2': nrm((L, GATE_LORA, R_WIDTH), GATE_LORA ** -0.5),
        'k_k': 0.85 + nrm((L, R_WIDTH), 0.05),
        'k_a': 1.0 + nrm((L, R_WIDTH), 0.05),
        'r_k': nrm((L, R_HEADS, R_HEAD), 0.1),
        'lnx_w': 1.0 + nrm((L, R_WIDTH), 0.05),
        'lnx_b': nrm((L, R_WIDTH), 0.01),
        'conv_w': nrm((L, CONV_K, 2 * M_HEADS * M_QK), CONV_K ** -0.5),
        'conv_b': nrm((L, 2 * M_HEADS * M_QK), 0.01),
        'i_bias': nrm((L, M_HEADS), 0.1),
        'f_bias': uni((L, M_HEADS), 3.0, 6.0),
        'mh_w': 1.0 + nrm((L, M_WIDTH), 0.05),
        'b_gate': nrm((L, GATE_COLS), 0.01),
        'w_br': nrm((L, R_WIDTH, D), BETA * R_WIDTH ** -0.5),
        'w_bm': nrm((L, M_WIDTH, D), BETA * M_WIDTH ** -0.5),
        'w_out': nrm((L, D, D), BETA * D ** -0.5),
        'ln1_w': 1.0 + nrm((L, D), 0.05),
        'ln1_b': nrm((L, D), 0.01),
        'w_rg': nrm((L, D, N_GROUPS), D ** -0.5),
        'b_rg': nrm((L, N_GROUPS), 0.01),
        'w_re': nrm((L, D, N_EXPERTS), D ** -0.5),
        'b_re': nrm((L, N_EXPERTS), 0.01),
        'w_gate': nrm((L, N_EXPERTS, D, D_EXPERT), BETA * D ** -0.5),
        'w_up': nrm((L, N_EXPERTS, D, D_EXPERT), BETA * D ** -0.5),
        'w_down': nrm((L, N_EXPERTS, D_EXPERT, D), BETA * D_EXPERT ** -0.5),
        'w_pg': nrm((L, D, D), D ** -0.5),
        'w_ple': nrm((L, PLE_DIM, D), BETA * PLE_DIM ** -0.5),
        'ln2_w': 1.0 + nrm((L, D), 0.05),
        'ln2_b': nrm((L, D), 0.01),
    }


def reference(x, p, w_in, mu_shift, w0, w_w2, a0, w_a2, w_g2, k_k, k_a, r_k, lnx_w, lnx_b,
              conv_w, conv_b, i_bias, f_bias, mh_w, b_gate, w_br, w_bm, w_out, ln1_w, ln1_b,
              w_rg, b_rg, w_re, b_re, w_gate, w_up, w_down, w_pg, w_ple, ln2_w, ln2_b):
    bsz, seq, d = x.shape
    for i in range(DEPTH):
        u = x @ w_in[i]
        u_r, u_m, u_g = _split(u, [RWKV_COLS, MLSTM_COLS, GATE_COLS])
        y_r = _rwkv7_mixer(u_r, mu_shift[i], w0[i], w_w2[i], a0[i], w_a2[i], w_g2[i],
                           k_k[i], k_a[i], r_k[i], lnx_w[i], lnx_b[i])
        y_m = _mlstm_mixer(u_m, conv_w[i], conv_b[i], i_bias[i], f_bias[i], mh_w[i])
        g_r, g_m = _split(u_g + b_gate[i], [d, d])
        mix = (jax.nn.sigmoid(g_r) * (y_r @ w_br[i])
               + jax.nn.sigmoid(g_m) * (y_m @ w_bm[i])) @ w_out[i]
        x = _layer_norm(ALPHA * x + mix, ln1_w[i], ln1_b[i])
        moe = _hier_moe(x.reshape(bsz * seq, d), w_rg[i], b_rg[i], w_re[i], b_re[i],
                        w_gate[i], w_up[i], w_down[i]).reshape(bsz, seq, d)
        ple = jax.nn.sigmoid(x @ w_pg[i]) * (p[i] @ w_ple[i])
        x = _layer_norm(ALPHA * x + moe + ple, ln2_w[i], ln2_b[i])
    return x
```

```cpp
#include <hip/hip_runtime.h>
#include <hip/hip_cooperative_groups.h>
#include <cstdio>
namespace cg = cooperative_groups;

typedef unsigned short u16;
using bf16x8 = __attribute__((ext_vector_type(8))) short;
using f32x4 = __attribute__((ext_vector_type(4))) float;
using f32x2 = __attribute__((ext_vector_type(2))) float;

constexpr int NT = 256;
constexpr int NTOK = 16384, DM = 2048, SEQ = 4096;
constexpr int UR_W = 3456, UM_W = 3200, UG_W = 4096;
constexpr float ALPHA_F = 1.189207115002721f;

constexpr size_t SZ_UR = (size_t)NTOK * UR_W * 2;
constexpr size_t SZ_UM = (size_t)NTOK * UM_W * 2;
constexpr size_t SZ_UG = (size_t)NTOK * UG_W * 2;
constexpr size_t SZ_XB = (size_t)NTOK * DM * 2;
constexpr size_t SZ_WINT = (size_t)10752 * 2048 * 2;
constexpr size_t SZ_PL = (size_t)NTOK * 1024 * 2;
constexpr size_t OFF_R0 = 0;
constexpr size_t OFF_R1 = OFF_R0 + SZ_UR;
constexpr size_t OFF_R2 = OFF_R1 + SZ_UM;
constexpr size_t OFF_R3 = OFF_R2 + SZ_UG;
constexpr size_t OFF_R4 = OFF_R3 + SZ_XB;
constexpr size_t OFF_R5 = OFF_R4 + SZ_WINT;
constexpr size_t OFF_WBRT = OFF_R5;
constexpr size_t OFF_WBMT = OFF_WBRT + (size_t)2048 * 1024 * 2;
constexpr size_t OFF_WOUTT = OFF_WBMT + (size_t)2048 * 1024 * 2;
constexpr size_t OFF_WPGT = OFF_WOUTT + (size_t)2048 * 2048 * 2;
constexpr size_t OFF_WPLET = OFF_WPGT + (size_t)2048 * 2048 * 2;
constexpr size_t OFF_WW2T = OFF_WPLET + (size_t)2048 * 256 * 2;
constexpr size_t OFF_WA2T = OFF_WW2T + (size_t)1024 * 64 * 2;
constexpr size_t OFF_WG2T = OFF_WA2T + (size_t)1024 * 64 * 2;
constexpr size_t OFF_PB = OFF_WG2T + (size_t)1024 * 192 * 2;
constexpr size_t OFF_WRH = OFF_PB + (size_t)NTOK * 256 * 2;
constexpr size_t OFF_WRL = OFF_WRH + (size_t)48 * 2048 * 2;
constexpr size_t OFF_FREE = OFF_WRL + (size_t)48 * 2048 * 2;
constexpr size_t OFF_UR = OFF_R0, OFF_UM = OFF_R1, OFF_UG = OFF_R2, OFF_XB = OFF_R3, OFF_WINT = OFF_R4;
constexpr size_t OFF_QC = OFF_R3;
constexpr size_t OFF_KC = OFF_QC + (size_t)NTOK * 512 * 2;
constexpr size_t OFF_KT = OFF_KC + (size_t)NTOK * 512 * 2;
constexpr size_t OFF_MISC = OFF_KT + (size_t)NTOK * 512 * 2;
constexpr size_t OFF_IPRE = OFF_MISC;
constexpr size_t OFF_LOGF = OFF_IPRE + (size_t)32 * 4096 * 4;
constexpr size_t OFF_ATOT = OFF_LOGF + (size_t)32 * 4096 * 4;
constexpr size_t OFF_GLMX = OFF_ATOT + 4096;
constexpr size_t OFF_MST = OFF_GLMX + 4096;
constexpr size_t OFF_DN = OFF_MST + 4096;
constexpr size_t OFF_VT = OFF_R4;
constexpr size_t OFF_LW = OFF_R4 + SZ_PL;
constexpr size_t OFF_LA = OFF_LW + (size_t)NTOK * 64 * 2;
constexpr size_t OFF_LG = OFF_LA + (size_t)NTOK * 64 * 2;
constexpr size_t OFF_YM = OFF_FREE;
constexpr size_t OFF_OMD = OFF_YM + SZ_PL;
constexpr size_t OFF_APL = OFF_OMD + SZ_PL;
constexpr size_t OFF_YR = OFF_APL;
constexpr size_t OFF_G = OFF_APL + SZ_PL;
constexpr size_t OFF_DC = OFF_G + SZ_PL;
constexpr size_t OFF_YRAW = OFF_DC;
constexpr size_t OFF_PR = OFF_R1;
constexpr size_t OFF_PK = OFF_PR + SZ_PL;
constexpr size_t OFF_PKK = OFF_PK + SZ_PL;
constexpr size_t OFF_PB2 = OFF_R3;
constexpr size_t OFF_PV = OFF_PB2 + SZ_PL;
constexpr size_t OFF_MIXPRE = OFF_R3;
constexpr size_t OFF_WGT = OFF_R0;
constexpr size_t OFF_WUT0 = OFF_WGT + (size_t)32 * 512 * 2048 * 2;
constexpr size_t OFF_WUT1 = OFF_R4 + ((size_t)4 << 20);
constexpr size_t OFF_WDT = OFF_R1;
constexpr size_t OFF_X1 = OFF_R2;
constexpr size_t OFF_X1B = OFF_R3;
constexpr size_t OFF_LIST = OFF_R4;
constexpr size_t OFF_WTS = OFF_LIST + (size_t)32 * 16384 * 4;
constexpr size_t OFF_CNT = OFF_WTS + (size_t)32768 * 4;
constexpr size_t OFF_H = OFF_FREE;
constexpr size_t OFF_MOEY = OFF_H + (size_t)36864 * 512 * 2;
constexpr size_t OFF_X1L = OFF_MOEY;
constexpr size_t OFF_BAR = OFF_MOEY + (size_t)32768 * 2048 * 2;
constexpr size_t WS_NEED = OFF_BAR + 16384;
static_assert(OFF_DC + (size_t)1024 * 128 * 64 * 4 <= WS_NEED, "ws");
static_assert(OFF_WUT0 + (size_t)22 * 512 * 2048 * 2 <= OFF_R1, "up0 fit");
static_assert(OFF_WUT1 + (size_t)10 * 512 * 2048 * 2 <= OFF_R5, "up1 fit");
static_assert(OFF_WDT + (size_t)32 * 512 * 2048 * 2 <= OFF_R2, "down fit");
static_assert(OFF_CNT + 128 <= OFF_WUT1, "lists fit");
static_assert(OFF_DN + 1024 * 64 * 4 <= OFF_R4, "misc fit");
static_assert(OFF_LG + (size_t)NTOK * 192 * 2 <= OFF_R5, "lora fit");
static_assert(OFF_PKK + SZ_PL <= OFF_R2, "planes fit");

struct Params {
  const float* in[36];
  float* out;
  char* ws;
};

__device__ __forceinline__ u16 f2bf(float f) { return __builtin_bit_cast(u16, (__bf16)f); }
__device__ __forceinline__ float bf2f(u16 h) { return __uint_as_float(((unsigned)h) << 16); }
typedef __bf16 bf16x2_t __attribute__((ext_vector_type(2)));
__device__ __forceinline__ unsigned pack2(float a, float b) {
  f32x2 v = {a, b};
  return __builtin_bit_cast(unsigned, __builtin_convertvector(v, bf16x2_t));
}
__device__ __forceinline__ float lo2f(unsigned u) { return __uint_as_float(u << 16); }
__device__ __forceinline__ float hi2f(unsigned u) { return __uint_as_float(u & 0xffff0000u); }
__device__ __forceinline__ float sigmoidf_(float x) { return __builtin_amdgcn_rcpf(1.f + __expf(-x)); }
__device__ __forceinline__ uint2 pack4(f32x4 v) { return make_uint2(pack2(v[0], v[1]), pack2(v[2], v[3])); }
__device__ __forceinline__ f32x4 unpack4(uint2 u) {
  f32x4 r; r[0] = lo2f(u.x); r[1] = hi2f(u.x); r[2] = lo2f(u.y); r[3] = hi2f(u.y); return r;
}
__device__ __forceinline__ int opaque_tid() {
  int t = threadIdx.x;
  asm volatile("" : "+v"(t));
  return t;
}
template <int CTRL>
__device__ __forceinline__ float dpp_add(float v) {
  int x = __builtin_amdgcn_update_dpp(0, __float_as_int(v), CTRL, 0xf, 0xf, true);
  return v + __int_as_float(x);
}
__device__ __forceinline__ float reduce16(float v) {
  v = dpp_add<0xB1>(v);
  v = dpp_add<0x4E>(v);
  v = dpp_add<0x141>(v);
  v = dpp_add<0x140>(v);
  return v;
}
__device__ __forceinline__ float wave_sum(float v) {
#pragma unroll
  for (int o = 32; o > 0; o >>= 1) v += __shfl_xor(v, o);
  return v;
}

template <typename T>
__device__ __forceinline__ T ldu(const void* ubase, unsigned voff) { return *(const T*)((const char*)ubase + voff); }
template <typename T>
__device__ __forceinline__ void stu(void* ubase, unsigned voff, T v) { *(T*)((char*)ubase + voff) = v; }

#define GLDS16(g, l) __builtin_amdgcn_global_load_lds((const unsigned*)(g), (unsigned*)(l), 16, 0, 0)

__device__ __forceinline__ void mainloop(u16* smem, const u16* (&ap)[4], const u16* (&bp)[4], int nk,
                                         f32x4 (&acc)[4][4]) {
  const int tid = opaque_tid(), lane = tid & 63, wid = tid >> 6;
  const int wr = wid >> 1, wc = wid & 1, fr = lane & 15, fq = lane >> 4;
  u16* sA = smem;
  u16* sB = smem + 16384;
  __syncthreads();
#pragma unroll
  for (int i = 0; i < 4; ++i) {
    GLDS16(ap[i], sA + (tid + i * 256) * 8);
    GLDS16(bp[i], sB + (tid + i * 256) * 8);
  }
  const int sw = fr >> 1;
  for (int kt = 0; kt < nk; ++kt) {
    asm volatile("s_waitcnt vmcnt(0)" ::: "memory");
    __syncthreads();
    const int buf = kt & 1;
    if (kt + 1 < nk) {
      const int ko = (kt + 1) * 64;
      u16* dA = sA + (buf ^ 1) * 8192;
      u16* dB = sB + (buf ^ 1) * 8192;
#pragma unroll
      for (int i = 0; i < 4; ++i) {
        GLDS16(ap[i] + ko, dA + (tid + i * 256) * 8);
        GLDS16(bp[i] + ko, dB + (tid + i * 256) * 8);
      }
    }
    const u16* cA = sA + buf * 8192 + (wr * 64 + fr) * 64;
    const u16* cB = sB + buf * 8192 + (wc * 64 + fr) * 64;
#pragma unroll
    for (int kk = 0; kk < 2; ++kk) {
      bf16x8 af[4], bfr[4];
      const int ch = ((kk * 4 + fq) ^ sw) * 8;
#pragma unroll
      for (int m = 0; m < 4; ++m) af[m] = *(const bf16x8*)(cA + m * 1024 + ch);
#pragma unroll
      for (int n = 0; n < 4; ++n) bfr[n] = *(const bf16x8*)(cB + n * 1024 + ch);
#pragma unroll
      for (int m = 0; m < 4; ++m)
#pragma unroll
        for (int n = 0; n < 4; ++n)
          acc[m][n] = __builtin_amdgcn_mfma_f32_16x16x32_bf16(bfr[n], af[m], acc[m][n], 0, 0, 0);
    }
  }
}


__device__ __forceinline__ void mainloop_chain(u16* smem, const u16* (&ap)[4], const u16* (&bp)[4], int nk,
                                               f32x4 (&acc)[4][4], bool first, bool has_next,
                                               const u16* (&nap)[4], const u16* (&nbp)[4]) {
  const int tid = opaque_tid(), lane = tid & 63, wid = tid >> 6;
  const int wr = wid >> 1, wc = wid & 1, fr = lane & 15, fq = lane >> 4;
  u16* sA = smem;
  u16* sB = smem + 16384;
  if (first) {
    __syncthreads();
#pragma unroll
    for (int i = 0; i < 4; ++i) {
      GLDS16(ap[i], sA + (tid + i * 256) * 8);
      GLDS16(bp[i], sB + (tid + i * 256) * 8);
    }
  }
  const int sw = fr >> 1;
  for (int kt = 0; kt < nk; ++kt) {
    asm volatile("s_waitcnt vmcnt(0)" ::: "memory");
    __syncthreads();
    const int buf = kt & 1;
    u16* dA = sA + (buf ^ 1) * 8192;
    u16* dB = sB + (buf ^ 1) * 8192;
    if (kt + 1 < nk) {
      const int ko = (kt + 1) * 64;
#pragma unroll
      for (int i = 0; i < 4; ++i) {
        GLDS16(ap[i] + ko, dA + (tid + i * 256) * 8);
        GLDS16(bp[i] + ko, dB + (tid + i * 256) * 8);
      }
    } else if (has_next) {
#pragma unroll
      for (int i = 0; i < 4; ++i) {
        GLDS16(nap[i], dA + (tid + i * 256) * 8);
        GLDS16(nbp[i], dB + (tid + i * 256) * 8);
      }
    }
    __builtin_amdgcn_sched_barrier(0);
    const u16* cA = sA + buf * 8192 + (wr * 64 + fr) * 64;
    const u16* cB = sB + buf * 8192 + (wc * 64 + fr) * 64;
#pragma unroll
    for (int kk = 0; kk < 2; ++kk) {
      bf16x8 af[4], bfr[4];
      const int ch = ((kk * 4 + fq) ^ sw) * 8;
#pragma unroll
      for (int m = 0; m < 4; ++m) af[m] = *(const bf16x8*)(cA + m * 1024 + ch);
#pragma unroll
      for (int n = 0; n < 4; ++n) bfr[n] = *(const bf16x8*)(cB + n * 1024 + ch);
      __builtin_amdgcn_s_setprio(1);
#pragma unroll
      for (int m = 0; m < 4; ++m)
#pragma unroll
        for (int n = 0; n < 4; ++n)
          acc[m][n] = __builtin_amdgcn_mfma_f32_16x16x32_bf16(bfr[n], af[m], acc[m][n], 0, 0, 0);
      __builtin_amdgcn_s_setprio(0);
    }
  }
}


__device__ __forceinline__ void mainloop_rs(u16* smem, const u16* (&ap)[4], const u16* (&bp)[4], int nk,
                                            f32x4 (&acc)[4][4]) {
  const int tid = opaque_tid(), lane = tid & 63, wid = tid >> 6;
  const int wr = wid >> 1, wc = wid & 1, fr = lane & 15, fq = lane >> 4;
  u16* sA = smem;
  u16* sB = smem + 16384;
  const int sw = fr >> 1;
  uint4 ra00, ra01, ra02, ra03, rb00, rb01, rb02, rb03, ra10, ra11, ra12, ra13, rb10, rb11, rb12, rb13;
#define RS_LD(S, KT)                                  \
  {                                                   \
    const int ko_ = (KT) * 64;                        \
    ra##S##0 = *(const uint4*)(ap[0] + ko_);          \
    rb##S##0 = *(const uint4*)(bp[0] + ko_);          \
    ra##S##1 = *(const uint4*)(ap[1] + ko_);          \
    rb##S##1 = *(const uint4*)(bp[1] + ko_);          \
    ra##S##2 = *(const uint4*)(ap[2] + ko_);          \
    rb##S##2 = *(const uint4*)(bp[2] + ko_);          \
    ra##S##3 = *(const uint4*)(ap[3] + ko_);          \
    rb##S##3 = *(const uint4*)(bp[3] + ko_);          \
  }
#define RS_ST(S, BUF)                                              \
  {                                                                \
    *(uint4*)(sA + (BUF) * 8192 + (tid + 0 * 256) * 8) = ra##S##0; \
    *(uint4*)(sB + (BUF) * 8192 + (tid + 0 * 256) * 8) = rb##S##0; \
    *(uint4*)(sA + (BUF) * 8192 + (tid + 1 * 256) * 8) = ra##S##1; \
    *(uint4*)(sB + (BUF) * 8192 + (tid + 1 * 256) * 8) = rb##S##1; \
    *(uint4*)(sA + (BUF) * 8192 + (tid + 2 * 256) * 8) = ra##S##2; \
    *(uint4*)(sB + (BUF) * 8192 + (tid + 2 * 256) * 8) = rb##S##2; \
    *(uint4*)(sA + (BUF) * 8192 + (tid + 3 * 256) * 8) = ra##S##3; \
    *(uint4*)(sB + (BUF) * 8192 + (tid + 3 * 256) * 8) = rb##S##3; \
  }
#define RS_COMPUTE(BUF)                                                                            \
  {                                                                                                \
    const u16* cA = sA + (BUF) * 8192 + (wr * 64 + fr) * 64;                                       \
    const u16* cB = sB + (BUF) * 8192 + (wc * 64 + fr) * 64;                                       \
    _Pragma("unroll") for (int kk = 0; kk < 2; ++kk) {                                             \
      bf16x8 af[4], bfr[4];                                                                        \
      const int ch = ((kk * 4 + fq) ^ sw) * 8;                                                     \
      _Pragma("unroll") for (int m = 0; m < 4; ++m) af[m] = *(const bf16x8*)(cA + m * 1024 + ch);  \
      _Pragma("unroll") for (int n = 0; n < 4; ++n) bfr[n] = *(const bf16x8*)(cB + n * 1024 + ch); \
      _Pragma("unroll") for (int m = 0; m < 4; ++m)                                                \
        _Pragma("unroll") for (int n = 0; n < 4; ++n)                                              \
          acc[m][n] = __builtin_amdgcn_mfma_f32_16x16x32_bf16(bfr[n], af[m], acc[m][n], 0, 0, 0);  \
    }                                                                                              \
  }
  __syncthreads();
  RS_LD(0, 0);
  RS_LD(1, min(1, nk - 1));
  RS_ST(0, 0);
  RS_LD(0, min(2, nk - 1));
  __syncthreads();
  for (int kt = 0; kt < nk; kt += 2) {
    RS_ST(1, 1);
    RS_LD(1, min(kt + 3, nk - 1));
    RS_COMPUTE(0);
    __syncthreads();
    if (kt + 1 < nk) {
      RS_ST(0, 0);
      RS_LD(0, min(kt + 4, nk - 1));
      RS_COMPUTE(1);
      __syncthreads();
    }
  }
#undef RS_LD
#undef RS_ST
#undef RS_COMPUTE
}

__device__ __forceinline__ void tile_map(int t, int ntm, int ntn, int& tm, int& tn) {
  const int nt = ntm * ntn;
  const int q = nt >> 3, r = nt & 7, xcd = t & 7, off = t >> 3;
  const int t2 = (xcd < r ? xcd * (q + 1) : r * (q + 1) + (xcd - r) * q) + off;
  const int nig = 8 * ntn;
  const int gid = t2 / nig, fm = gid * 8;
  const int gsz = min(ntm - fm, 8);
  tm = fm + (t2 % nig) % gsz;
  tn = (t2 % nig) / gsz;
}

template <class Epi>
__device__ __forceinline__ void gemm_plain(u16* smem, const u16* A, int lda, const u16* Bt, int ldb, int M, int N,
                                           int K, Epi epi) {
  const int ntm = M >> 7, ntn = N >> 7, ntiles = ntm * ntn, nk = K >> 6;
  const int tid = opaque_tid(), lane = tid & 63, wid = tid >> 6;
  const int wr = wid >> 1, wc = wid & 1, fr = lane & 15, fq = lane >> 4;
  const int r = tid >> 3, c = ((tid & 7) ^ ((tid >> 4) & 7)) * 8;
  const bool chain = (nk & 1) == 0;
  int t = blockIdx.x;
  if (t >= ntiles) return;
  int tm, tn;
  tile_map(t, ntm, ntn, tm, tn);
  int m0 = tm << 7, n0 = tn << 7;
  const u16* ap[4];
  const u16* bp[4];
#pragma unroll
  for (int i = 0; i < 4; ++i) {
    ap[i] = A + (size_t)(m0 + r + 32 * i) * lda + c;
    bp[i] = Bt + (size_t)(n0 + r + 32 * i) * ldb + c;
  }
  bool first = true;
  for (; t < ntiles; t += gridDim.x) {
    const int t2 = t + gridDim.x;
    const bool has_next = chain && (t2 < ntiles);
    int nm0 = m0, nn0 = n0;
    if (t2 < ntiles) {
      int tm2, tn2;
      tile_map(t2, ntm, ntn, tm2, tn2);
      nm0 = tm2 << 7; nn0 = tn2 << 7;
    }
    const u16* nap[4];
    const u16* nbp[4];
#pragma unroll
    for (int i = 0; i < 4; ++i) {
      nap[i] = A + (size_t)(nm0 + r + 32 * i) * lda + c;
      nbp[i] = Bt + (size_t)(nn0 + r + 32 * i) * ldb + c;
    }
    f32x4 acc[4][4];
#pragma unroll
    for (int m = 0; m < 4; ++m)
#pragma unroll
      for (int n = 0; n < 4; ++n) acc[m][n] = f32x4{0.f, 0.f, 0.f, 0.f};
    mainloop_chain(smem, ap, bp, nk, acc, first, has_next, nap, nbp);
    first = !chain;
#pragma unroll
    for (int m = 0; m < 4; ++m)
#pragma unroll
      for (int n = 0; n < 4; ++n) epi(m0 + wr * 64 + m * 16 + fr, n0 + wc * 64 + n * 16 + fq * 4, acc[m][n]);
    m0 = nm0; n0 = nn0;
#pragma unroll
    for (int i = 0; i < 4; ++i) { ap[i] = nap[i]; bp[i] = nbp[i]; }
  }
}

__device__ __forceinline__ void conv_flat(const float* src, u16* dst, size_t n, int bid, int nb) {
  const size_t stride = (size_t)nb * NT * 8;
  for (size_t i = ((size_t)bid * NT + opaque_tid()) * 8; i < n; i += stride) {
    const float4 a = *(const float4*)(src + i), b = *(const float4*)(src + i + 4);
    uint4 o = make_uint4(pack2(a.x, a.y), pack2(a.z, a.w), pack2(b.x, b.y), pack2(b.z, b.w));
    *(uint4*)(dst + i) = o;
  }
}

struct TJob {
  const float* src; u16* dst;
  int K, Kpad, N, ldsrc, lddst, nbatch;
  long sbs, dbs;
  int ntiles, pad_;
};
__device__ __forceinline__ void set_job(TJob& j, const float* src, u16* dst, int K, int Kpad, int N, int ldsrc,
                                        int lddst, int nbatch, long sbs, long dbs) {
  j.src = src; j.dst = dst; j.K = K; j.Kpad = Kpad; j.N = N; j.ldsrc = ldsrc; j.lddst = lddst; j.nbatch = nbatch;
  j.sbs = sbs; j.dbs = dbs; j.ntiles = nbatch * (Kpad >> 6) * ((N + 63) >> 6); j.pad_ = 0;
}
__device__ __forceinline__ void run_tjobs(const TJob* jobs, int nj, float* tile, int bid, int nb) {
  u16* tt = (u16*)tile;
  int total = 0;
  for (int j = 0; j < nj; ++j) total += jobs[j].ntiles;
  const int tid = opaque_tid();
  for (int t = bid; t < total; t += nb) {
    int j = 0, loc = t;
    while (loc >= jobs[j].ntiles) { loc -= jobs[j].ntiles; ++j; }
    const TJob& jb = jobs[j];
    const int tk = jb.Kpad >> 6, tn = (jb.N + 63) >> 6;
    const int b = loc / (tk * tn);
    const int rem = loc - b * (tk * tn);
    const int k0 = (rem / tn) << 6, n0 = (rem % tn) << 6;
    const float* src = jb.src + (size_t)b * jb.sbs;
    u16* dst = jb.dst + (size_t)b * jb.dbs;
    __syncthreads();
    {
      const int kr = tid >> 4, nq = (tid & 15) * 4;
      const bool nok = (n0 + nq) < jb.N;
#pragma unroll
      for (int i = 0; i < 4; ++i) {
        const int k = kr + 16 * i;
        float4 v = make_float4(0.f, 0.f, 0.f, 0.f);
        if (nok && (k0 + k) < jb.K) v = *(const float4*)(src + (size_t)(k0 + k) * jb.ldsrc + n0 + nq);
        tt[(nq + 0) * 66 + k] = f2bf(v.x);
        tt[(nq + 1) * 66 + k] = f2bf(v.y);
        tt[(nq + 2) * 66 + k] = f2bf(v.z);
        tt[(nq + 3) * 66 + k] = f2bf(v.w);
      }
    }
    __syncthreads();
    {
      const int n = tid >> 2, kc = (tid & 3) * 16;
      if (n0 + n < jb.N) {
        const unsigned* rp = (const unsigned*)(tt + n * 66 + kc);
        uint4 o0 = make_uint4(rp[0], rp[1], rp[2], rp[3]);
        uint4 o1 = make_uint4(rp[4], rp[5], rp[6], rp[7]);
        uint4* dp = (uint4*)(dst + (size_t)(n0 + n) * jb.lddst + k0 + kc);
        dp[0] = o0;
        dp[1] = o1;
      }
    }
  }
}

__device__ __forceinline__ void phase0(const Params& p, char* smem_c) {
  char* ws = p.ws;
  TJob* jobs = (TJob*)smem_c;
  float* tile = (float*)(smem_c + 2048);
  if (threadIdx.x == 0) {
    const float* w_in = p.in[2];
    u16* wint = (u16*)(ws + OFF_WINT);
    set_job(jobs[0], w_in, wint, 2048, 2048, 3360, 10544, 2048, 1, 0, 0);
    set_job(jobs[1], w_in + 3360, wint + (size_t)3456 * 2048, 2048, 2048, 3088, 10544, 2048, 1, 0, 0);
    set_job(jobs[2], w_in + 6448, wint + (size_t)6656 * 2048, 2048, 2048, 4096, 10544, 2048, 1, 0, 0);
    set_job(jobs[3], p.in[5], (u16*)(ws + OFF_WW2T), 64, 64, 1024, 1024, 64, 1, 0, 0);
    set_job(jobs[4], p.in[7], (u16*)(ws + OFF_WA2T), 64, 64, 1024, 1024, 64, 1, 0, 0);
    set_job(jobs[5], p.in[8], (u16*)(ws + OFF_WG2T), 160, 192, 1024, 1024, 192, 1, 0, 0);
  }
  __syncthreads();
  run_tjobs(jobs, 6, tile, blockIdx.x, gridDim.x);
  conv_flat(p.in[0], (u16*)(ws + OFF_XB), (size_t)NTOK * DM, blockIdx.x, gridDim.x);
  const int gtid = blockIdx.x * NT + opaque_tid(), gsz = gridDim.x * NT;
  {
    unsigned* w = (unsigned*)(ws + OFF_WINT);
    for (int i = gtid; i < 96 * 1024; i += gsz) w[(size_t)3360 * 1024 + i] = 0u;
    for (int i = gtid; i < 112 * 1024; i += gsz) w[(size_t)6544 * 1024 + i] = 0u;
  }
  {
    u16* wh = (u16*)(ws + OFF_WRH);
    u16* wl = (u16*)(ws + OFF_WRL);
    const float* w_rg = p.in[25];
    const float* w_re = p.in[27];
    for (int i = gtid; i < 48 * 2048; i += gsz) {
      const int n = i >> 11, k = i & 2047;
      float v = 0.f;
      if (n < 4) v = w_rg[k * 4 + n];
      else if (n < 36) v = w_re[k * 32 + (n - 4)];
      const u16 h = f2bf(v);
      wh[i] = h;
      wl[i] = f2bf(v - bf2f(h));
    }
  }
}

__device__ __forceinline__ void phase1(const Params& p, u16* smem) {
  char* ws = p.ws;
  u16* ur = (u16*)(ws + OFF_UR);
  u16* um = (u16*)(ws + OFF_UM);
  u16* ug = (u16*)(ws + OFF_UG);
  gemm_plain(smem, (const u16*)(ws + OFF_XB), 2048, (const u16*)(ws + OFF_WINT), 2048, NTOK, 10752, 2048,
             [=](int row, int col, f32x4 v) {
               u16* dst;
               if (col < 3456) dst = ur + (size_t)row * UR_W + col;
               else if (col < 6656) dst = um + (size_t)row * UM_W + (col - 3456);
               else dst = ug + (size_t)row * UG_W + (col - 6656);
               *(uint2*)dst = pack4(v);
             });
}

__device__ __forceinline__ void phase2(const Params& p, u16* smem) {
  char* ws = p.ws;
  const u16* um = (const u16*)(ws + OFF_UM);
  const u16* ur = (const u16*)(ws + OFF_UR);
  u16* qc = (u16*)(ws + OFF_QC);
  u16* kc = (u16*)(ws + OFF_KC);
  u16* kT = (u16*)(ws + OFF_KT);
  u16* vT = (u16*)(ws + OFF_VT);
  const float* conv_w = p.in[14];
  const float* conv_b = p.in[15];
  const int tid = opaque_tid();
  u16* tile = smem;
  for (int t = blockIdx.x; t < 8192; t += gridDim.x) {
    const int tb = t >> 5, cb = t & 31;
    const int tok0 = tb * 64, b = tok0 >> 12, ts0 = tok0 & 4095;
    const int tl = tid >> 2, cs = (tid & 3) * 16;
    const int tok = tok0 + tl;
    float val[16];
    if (cb < 16) {
      const int col0 = cb * 64 + cs;
#pragma unroll
      for (int e = 0; e < 16; ++e) val[e] = conv_b[col0 + e];
#pragma unroll
      for (int j = 0; j < 4; ++j) {
        const int ts = ts0 + tl - 3 + j;
        if (ts >= 0) {
          const uint4* src = (const uint4*)(um + (size_t)(b * 4096 + ts) * UM_W + col0);
          const uint4 a = src[0], c4 = src[1];
          const unsigned w[8] = {a.x, a.y, a.z, a.w, c4.x, c4.y, c4.z, c4.w};
#pragma unroll
          for (int e = 0; e < 8; ++e) {
            val[2 * e] += conv_w[j * 1024 + col0 + 2 * e] * lo2f(w[e]);
            val[2 * e + 1] += conv_w[j * 1024 + col0 + 2 * e + 1] * hi2f(w[e]);
          }
        }
      }
      const float sc = (cb >= 8) ? 0.125f : 1.0f;
#pragma unroll
      for (int e = 0; e < 16; ++e) val[e] = val[e] * sigmoidf_(val[e]) * sc;
      u16* dst = (cb < 8) ? (qc + (size_t)tok * 512 + col0) : (kc + (size_t)tok * 512 + (col0 - 512));
      uint4 o0 = make_uint4(pack2(val[0], val[1]), pack2(val[2], val[3]), pack2(val[4], val[5]), pack2(val[6], val[7]));
      uint4 o1 = make_uint4(pack2(val[8], val[9]), pack2(val[10], val[11]), pack2(val[12], val[13]), pack2(val[14], val[15]));
      ((uint4*)dst)[0] = o0;
      ((uint4*)dst)[1] = o1;
    } else {
      const int col0 = 1024 + (cb - 16) * 64 + cs;
      const uint4* src = (const uint4*)(um + (size_t)tok * UM_W + col0);
      const uint4 a = src[0], c4 = src[1];
      const unsigned w[8] = {a.x, a.y, a.z, a.w, c4.x, c4.y, c4.z, c4.w};
#pragma unroll
      for (int e = 0; e < 8; ++e) { val[2 * e] = lo2f(w[e]); val[2 * e + 1] = hi2f(w[e]); }
    }
    __syncthreads();
    if (cb >= 8) {
#pragma unroll
      for (int e = 0; e < 16; ++e) tile[tl * 66 + cs + e] = f2bf(val[e]);
    }
    __syncthreads();
    if (cb >= 8) {
      const int ch = tid >> 2, t4 = (tid & 3) * 16;
      unsigned o[8];
#pragma unroll
      for (int e = 0; e < 8; ++e)
        o[e] = (unsigned)tile[(t4 + 2 * e) * 66 + ch] | ((unsigned)tile[(t4 + 2 * e + 1) * 66 + ch] << 16);
      u16* dst;
      if (cb < 16) dst = kT + ((size_t)((b * 8 + (cb - 8)) * 64 + ch)) * 4096 + ts0 + t4;
      else dst = vT + ((size_t)((b * 8 + ((cb - 16) >> 1)) * 128 + ((cb - 16) & 1) * 64 + ch)) * 4096 + ts0 + t4;
      ((uint4*)dst)[0] = make_uint4(o[0], o[1], o[2], o[3]);
      ((uint4*)dst)[1] = make_uint4(o[4], o[5], o[6], o[7]);
    }
  }
  const int gtid = blockIdx.x * NT + tid, gsz = gridDim.x * NT;
  {
    float* ipre = (float*)(ws + OFF_IPRE);
    float* logf = (float*)(ws + OFF_LOGF);
    const float* i_bias = p.in[16];
    const float* f_bias = p.in[17];
    for (int i = gtid; i < NTOK * 8; i += gsz) {
      const int tok = i >> 3, h = i & 7, b = tok >> 12, ts = tok & 4095;
      const float ig = bf2f(um[(size_t)tok * UM_W + 2048 + h]) + i_bias[h];
      const float fg = bf2f(um[(size_t)tok * UM_W + 2056 + h]) + f_bias[h];
      const float lf = fminf(fg, 0.f) - log1pf(__expf(-fabsf(fg)));
      ipre[(b * 8 + h) * 4096 + ts] = ig;
      logf[(b * 8 + h) * 4096 + ts] = lf;
    }
  }
  {
    u16* lw = (u16*)(ws + OFF_LW);
    u16* la = (u16*)(ws + OFF_LA);
    u16* lg = (u16*)(ws + OFF_LG);
    const float* mu = p.in[3];
    for (int i = gtid; i < NTOK * 320; i += gsz) {
      const int tok = i / 320, j = i - tok * 320;
      if (j >= 288) { lg[(size_t)tok * 192 + 160 + (j - 288)] = 0; continue; }
      const int col = 3072 + j;
      const float z = bf2f(ur[(size_t)tok * UR_W + col]);
      const float zpl = bf2f(ur[(size_t)(((tok & 4095) > 0) ? tok - 1 : tok) * UR_W + col]);
      const float zp = ((tok & 4095) > 0) ? zpl : 0.f;
      const float zs = z + mu[col] * (zp - z);
      if (j < 64) lw[(size_t)tok * 64 + j] = f2bf(tanhf(zs));
      else if (j < 128) la[(size_t)tok * 64 + (j - 64)] = f2bf(zs);
      else lg[(size_t)tok * 192 + (j - 128)] = f2bf(sigmoidf_(zs));
    }
  }
}

__device__ __forceinline__ void chunk_gates(const Params& p, int bh, int t0, float* fbuf, float* ibuf, float* abuf) {
  const float* ipre = (const float*)(p.ws + OFF_IPRE);
  const float* logf = (const float*)(p.ws + OFF_LOGF);
  const int tid = opaque_tid();
  __syncthreads();
  if (tid < 64) {
    const float2 f = *(const float2*)(logf + bh * 4096 + t0 + 2 * tid);
    const float2 iv = *(const float2*)(ipre + bh * 4096 + t0 + 2 * tid);
    const float pair = f.x + f.y;
    float inc = pair;
#pragma unroll
    for (int o = 1; o < 64; o <<= 1) {
      const float up = __shfl_up(inc, o);
      if (tid >= o) inc += up;
    }
    const float excl = inc - pair;
    *(float2*)(fbuf + 2 * tid) = f;
    *(float2*)(ibuf + 2 * tid) = iv;
    *(float2*)(abuf + 2 * tid) = make_float2(excl + f.x, inc);
  }
  __syncthreads();
}

__device__ __forceinline__ void phase3(const Params& p, u16* smem) {
  char* ws = p.ws;
  const int tid = opaque_tid(), lane = tid & 63, wid = tid >> 6, fr = lane & 15, fq = lane >> 4;
  float* sf = (float*)smem;
  float* fbuf = sf, *ibuf = sf + 128, *abuf = sf + 256, *gebuf = sf + 384;
  const u16* kT = (const u16*)(ws + OFF_KT);
  const u16* vT = (const u16*)(ws + OFF_VT);
  float* dC = (float*)(ws + OFF_DC);
  float* dn = (float*)(ws + OFF_DN);
  float* atot = (float*)(ws + OFF_ATOT);
  float* glmx = (float*)(ws + OFF_GLMX);
  for (int unit = blockIdx.x; unit < 1024; unit += gridDim.x) {
    const int bh = unit >> 5, c = unit & 31, t0 = c * 128;
    chunk_gates(p, bh, t0, fbuf, ibuf, abuf);
    const float a_tot = abuf[127];
    float glmax = fmaxf(a_tot - abuf[lane] + ibuf[lane], a_tot - abuf[lane + 64] + ibuf[lane + 64]);
#pragma unroll
    for (int o = 32; o > 0; o >>= 1) glmax = fmaxf(glmax, __shfl_xor(glmax, o));
    if (tid < 128) gebuf[tid] = __expf(a_tot - abuf[tid] + ibuf[tid] - glmax);
    if (tid == 0) { atot[unit] = a_tot; glmx[unit] = glmax; }
    __syncthreads();
    f32x4 acc[2][4];
#pragma unroll
    for (int m = 0; m < 2; ++m)
#pragma unroll
      for (int n = 0; n < 4; ++n) acc[m][n] = f32x4{0.f, 0.f, 0.f, 0.f};
#pragma unroll
    for (int ks = 0; ks < 4; ++ks) {
      const int s0 = ks * 32 + fq * 8;
      bf16x8 rf[2], cf[4];
#pragma unroll
      for (int m = 0; m < 2; ++m)
        rf[m] = *(const bf16x8*)(vT + (size_t)(bh * 128 + wid * 32 + m * 16 + fr) * 4096 + t0 + s0);
#pragma unroll
      for (int n = 0; n < 4; ++n) {
        const bf16x8 raw = *(const bf16x8*)(kT + (size_t)(bh * 64 + n * 16 + fr) * 4096 + t0 + s0);
        bf16x8 sc;
#pragma unroll
        for (int j = 0; j < 8; ++j) sc[j] = (short)f2bf(bf2f((u16)raw[j]) * gebuf[s0 + j]);
        cf[n] = sc;
      }
#pragma unroll
      for (int m = 0; m < 2; ++m)
#pragma unroll
        for (int n = 0; n < 4; ++n) acc[m][n] = __builtin_amdgcn_mfma_f32_16x16x32_bf16(cf[n], rf[m], acc[m][n], 0, 0, 0);
    }
#pragma unroll
    for (int m = 0; m < 2; ++m)
#pragma unroll
      for (int n = 0; n < 4; ++n) {
        const int e = wid * 32 + m * 16 + fr, d = n * 16 + fq * 4;
        *(f32x4*)(dC + ((size_t)unit * 128 + e) * 64 + d) = acc[m][n];
      }
    if (tid < 64) {
      float s = 0.f;
      const u16* kr = kT + (size_t)(bh * 64 + tid) * 4096 + t0;
      for (int q = 0; q < 128; ++q) s += gebuf[q] * bf2f(kr[q]);
      dn[unit * 64 + tid] = s;
    }
  }
  {
    const float* w0 = p.in[4];
    u16* omd = (u16*)(ws + OFF_OMD);
    gemm_plain(smem, (const u16*)(ws + OFF_LW), 64, (const u16*)(ws + OFF_WW2T), 64, NTOK, 1024, 64,
               [=](int row, int col, f32x4 v) {
                 f32x4 o;
#pragma unroll
                 for (int j = 0; j < 4; ++j) {
                   const float z = w0[col + j] + v[j];
                   const float sp = fmaxf(-z, 0.f) + log1pf(__expf(-fabsf(z)));
                   const float w = -sp - 0.5f;
                   o[j] = -expm1f(-__expf(w));
                 }
                 *(uint2*)(omd + (size_t)row * 1024 + col) = pack4(o);
               });
    const float* a0 = p.in[6];
    u16* apl = (u16*)(ws + OFF_APL);
    gemm_plain(smem, (const u16*)(ws + OFF_LA), 64, (const u16*)(ws + OFF_WA2T), 64, NTOK, 1024, 64,
               [=](int row, int col, f32x4 v) {
                 f32x4 o;
#pragma unroll
                 for (int j = 0; j < 4; ++j) o[j] = sigmoidf_(a0[col + j] + v[j]);
                 *(uint2*)(apl + (size_t)row * 1024 + col) = pack4(o);
               });
    u16* g = (u16*)(ws + OFF_G);
    gemm_plain(smem, (const u16*)(ws + OFF_LG), 192, (const u16*)(ws + OFF_WG2T), 192, NTOK, 1024, 192,
               [=](int row, int col, f32x4 v) { *(uint2*)(g + (size_t)row * 1024 + col) = pack4(v); });
  }
}

__device__ __forceinline__ void phase4(const Params& p) {
  char* ws = p.ws;
  float* dC = (float*)(ws + OFF_DC);
  float* dn = (float*)(ws + OFF_DN);
  const float* atot = (const float*)(ws + OFF_ATOT);
  const float* glmx = (const float*)(ws + OFF_GLMX);
  float* mst = (float*)(ws + OFF_MST);
  const int gtid = blockIdx.x * NT + opaque_tid(), gsz = gridDim.x * NT;
  for (int idx = gtid; idx < 32 * 8256; idx += gsz) {
    const int bh = idx / 8256, e = idx - bh * 8256;
    float C = 0.f, m = -1.0e30f;
    float* qb = (e < 8192) ? (dC + (size_t)bh * 32 * 8192 + e) : (dn + bh * 32 * 64 + (e - 8192));
    const size_t qs = (e < 8192) ? 8192 : 64;
#pragma unroll 1
    for (int cb = 0; cb < 32; cb += 8) {
      float v[8], at[8], gm[8];
#pragma unroll
      for (int j = 0; j < 8; ++j) { v[j] = qb[(size_t)(cb + j) * qs]; at[j] = atot[bh * 32 + cb + j]; gm[j] = glmx[bh * 32 + cb + j]; }
#pragma unroll
      for (int j = 0; j < 8; ++j) {
        qb[(size_t)(cb + j) * qs] = C;
        if (e == 0) mst[bh * 32 + cb + j] = m;
        const float mn = fmaxf(at[j] + m, gm[j]);
        C = __expf(at[j] + m - mn) * C + __expf(gm[j] - mn) * v[j];
        m = mn;
      }
    }
  }
}

__device__ __forceinline__ void phase5(const Params& p, u16* smem) {
  char* ws = p.ws;
  const int tid = opaque_tid(), lane = tid & 63, fr = lane & 15, fq = lane >> 4;
  const int wid = __builtin_amdgcn_readfirstlane(tid >> 6);
  float* sf = (float*)smem;
  float* fbuf = sf, *ibuf = sf + 128, *abuf = sf + 256, *iabuf = sf + 384, *pmbuf = sf + 512;
  u16* Pb = smem + 2048 + wid * (32 * 136);
  const u16* qc = (const u16*)(ws + OFF_QC);
  const u16* kc = (const u16*)(ws + OFF_KC);
  const u16* vT = (const u16*)(ws + OFF_VT);
  const u16* um = (const u16*)(ws + OFF_UM);
  const float* Cst = (const float*)(ws + OFF_DC);
  const float* nst = (const float*)(ws + OFF_DN);
  const float* mstv = (const float*)(ws + OFF_MST);
  const float* mh_w = p.in[18];
  u16* ym = (u16*)(ws + OFF_YM);
  const unsigned vq = (unsigned)(fr * 512 + fq * 8) * 2u;
  const unsigned vc = (unsigned)(fr * 64 + fq * 8) * 4u;
  const unsigned vv = (unsigned)(fr * 4096 + fq * 8) * 2u;
  const unsigned vo = (unsigned)(fr * UM_W + fq * 4) * 2u;
  const unsigned vy = (unsigned)(fr * 1024 + fq * 4) * 2u;
  const unsigned vq2 = (unsigned)(fr * 512 + fq * 16) * 2u;
  for (int unit = blockIdx.x; unit < 1024; unit += gridDim.x) {
    const int bh = unit >> 5, c = unit & 31, t0 = c * 128, b = bh >> 3, h = bh & 7;
    chunk_gates(p, bh, t0, fbuf, ibuf, abuf);
    if (tid < 64) {
      const float2 iv = *(const float2*)(ibuf + 2 * tid);
      const float2 av = *(const float2*)(abuf + 2 * tid);
      const float ia0 = iv.x - av.x, ia1 = iv.y - av.y;
      const float m1 = fmaxf(ia0, ia1);
      float inc = m1;
#pragma unroll
      for (int o = 1; o < 64; o <<= 1) {
        const float up = __shfl_up(inc, o);
        if (tid >= o) inc = fmaxf(inc, up);
      }
      float excl = __shfl_up(inc, 1);
      if (tid == 0) excl = -3.0e38f;
      *(float2*)(iabuf + 2 * tid) = make_float2(ia0, ia1);
      *(float2*)(pmbuf + 2 * tid) = make_float2(fmaxf(excl, ia0), inc);
    }
    __syncthreads();
    const float mst = mstv[unit];
    const size_t tokbase = (size_t)b * 4096 + t0;
    const u16* kbase = kc + tokbase * 512 + h * 64;
    const float* cbase = Cst + (size_t)unit * 8192;
    const u16* vbase = vT + (size_t)bh * 128 * 4096 + t0;
#pragma unroll 1
    for (int mt = 0; mt < 2; ++mt) {
      const int trow = wid * 32 + mt * 16;
      const int t = trow + fr;
      const u16* qbase = qc + (tokbase + trow) * 512 + h * 64;
      bf16x8 Qf[2];
#pragma unroll
      for (int kk = 0; kk < 2; ++kk) Qf[kk] = ldu<bf16x8>(qbase + kk * 32, vq);
      const float Mt = fmaxf(mst, pmbuf[t]);
      const int dt = t - fq * 4;
      const float ie = __expf(mst - Mt);
      float rowsum = 0.f;
      {
        f32x4 S[8];
#pragma unroll
        for (int n = 0; n < 8; ++n) S[n] = f32x4{0.f, 0.f, 0.f, 0.f};
#pragma unroll
        for (int kk = 0; kk < 2; ++kk) {
#pragma unroll
          for (int n = 0; n < 8; ++n) {
            const bf16x8 kf = ldu<bf16x8>(kbase + n * 16 * 512 + kk * 32, vq);
            S[n] = __builtin_amdgcn_mfma_f32_16x16x32_bf16(kf, Qf[kk], S[n], 0, 0, 0);
          }
        }
#pragma unroll
        for (int n = 0; n < 8; ++n) {
          const f32x4 ia4 = *(const f32x4*)(iabuf + n * 16 + fq * 4);
          f32x4 pv;
#pragma unroll
          for (int j = 0; j < 4; ++j) {
            const float w = __expf((n * 16 + j <= dt) ? (ia4[j] - Mt) : -1.0e30f);
            pv[j] = S[n][j] * w;
            rowsum += pv[j];
          }
          *(uint2*)(Pb + (mt * 16 + fr) * 136 + n * 16 + fq * 4) = pack4(pv);
        }
        rowsum += __shfl_xor(rowsum, 16);
        rowsum += __shfl_xor(rowsum, 32);
      }
      __syncthreads();
      f32x4 acc[8];
#pragma unroll
      for (int n = 0; n < 8; ++n) acc[n] = f32x4{0.f, 0.f, 0.f, 0.f};
#pragma unroll
      for (int kk = 0; kk < 2; ++kk) {
#pragma unroll
        for (int n = 0; n < 8; ++n) {
          const float4 c0 = ldu<float4>(cbase + n * 16 * 64 + kk * 32, vc);
          const float4 c1 = ldu<float4>(cbase + n * 16 * 64 + kk * 32 + 4, vc);
          bf16x8 cf;
          cf[0] = (short)f2bf(c0.x); cf[1] = (short)f2bf(c0.y); cf[2] = (short)f2bf(c0.z); cf[3] = (short)f2bf(c0.w);
          cf[4] = (short)f2bf(c1.x); cf[5] = (short)f2bf(c1.y); cf[6] = (short)f2bf(c1.z); cf[7] = (short)f2bf(c1.w);
          acc[n] = __builtin_amdgcn_mfma_f32_16x16x32_bf16(cf, Qf[kk], acc[n], 0, 0, 0);
        }
      }
#pragma unroll
      for (int n = 0; n < 8; ++n)
#pragma unroll
        for (int j = 0; j < 4; ++j) acc[n][j] *= ie;
#pragma unroll
      for (int ks = 0; ks < 4; ++ks) {
        const bf16x8 pf = *(const bf16x8*)(Pb + (mt * 16 + fr) * 136 + ks * 32 + fq * 8);
#pragma unroll
        for (int n = 0; n < 8; ++n) {
          const bf16x8 vf = ldu<bf16x8>(vbase + (size_t)n * 16 * 4096 + ks * 32, vv);
          acc[n] = __builtin_amdgcn_mfma_f32_16x16x32_bf16(vf, pf, acc[n], 0, 0, 0);
        }
      }
      float qn = 0.f;
      {
        const float* np = nst + unit * 64 + fq * 16;
#pragma unroll
        for (int j8 = 0; j8 < 2; ++j8) {
          const bf16x8 q8 = ldu<bf16x8>(qbase + j8 * 8, vq2);
#pragma unroll
          for (int j = 0; j < 8; ++j) qn += bf2f((u16)q8[j]) * np[j8 * 8 + j];
        }
        qn += __shfl_xor(qn, 16);
        qn += __shfl_xor(qn, 32);
      }
      const float den = ie * qn + rowsum;
      const float mfull = abuf[t] + Mt;
      const float dd = fmaxf(fabsf(den), __expf(-mfull));
      const float inv = __builtin_amdgcn_rcpf(dd);
      float s1 = 0.f;
#pragma unroll
      for (int n = 0; n < 8; ++n)
#pragma unroll
        for (int j = 0; j < 4; ++j) { acc[n][j] *= inv; s1 += acc[n][j]; }
      s1 += __shfl_xor(s1, 16);
      s1 += __shfl_xor(s1, 32);
      const float mean = s1 * (1.f / 128.f);
      float s2 = 0.f;
#pragma unroll
      for (int n = 0; n < 8; ++n)
#pragma unroll
        for (int j = 0; j < 4; ++j) { const float d = acc[n][j] - mean; s2 += d * d; }
      s2 += __shfl_xor(s2, 16);
      s2 += __shfl_xor(s2, 32);
      const float rstd = rsqrtf(s2 * (1.f / 128.f) + 1e-6f);
      const u16* obase = um + (tokbase + trow) * UM_W + 2064 + h * 128;
      u16* ybase = ym + (tokbase + trow) * 1024 + h * 128;
#pragma unroll
      for (int n = 0; n < 8; ++n) {
        const f32x4 o = unpack4(ldu<uint2>(obase + n * 16, vo));
        const f32x4 mw = *(const f32x4*)(mh_w + h * 128 + n * 16 + fq * 4);
        f32x4 y;
#pragma unroll
        for (int j = 0; j < 4; ++j) y[j] = (acc[n][j] - mean) * rstd * mw[j] * sigmoidf_(o[j]);
        stu<uint2>(ybase + n * 16, vy, pack4(y));
      }
      asm volatile("" ::: "memory");
    }
  }
}

__device__ __forceinline__ void phase6(const Params& p) {
  char* ws = p.ws;
  const u16* ur = (const u16*)(ws + OFF_UR);
  const u16* apl = (const u16*)(ws + OFF_APL);
  u16* __restrict__ PR = (u16*)(ws + OFF_PR);
  u16* __restrict__ PK = (u16*)(ws + OFF_PK);
  u16* __restrict__ PKK = (u16*)(ws + OFF_PKK);
  u16* __restrict__ PBp = (u16*)(ws + OFF_PB2);
  u16* __restrict__ PV = (u16*)(ws + OFF_PV);
  const float* mu = p.in[3];
  const float* k_k = p.in[9];
  const float* k_a = p.in[10];
  const int gtid = blockIdx.x * NT + opaque_tid(), gsz = gridDim.x * NT;
#pragma unroll 2
  for (int i = gtid; i < NTOK * 256; i += gsz) {
    const int tok = i >> 8, c0 = (i & 255) * 4;
    const bool has_prev = (tok & 4095) > 0;
    const u16* cur = ur + (size_t)tok * UR_W + c0;
    const u16* prv = has_prev ? (cur - UR_W) : cur;
    f32x4 z[3];
#pragma unroll
    for (int q = 0; q < 3; ++q) {
      const f32x4 zc = unpack4(*(const uint2*)(cur + q * 1024));
      f32x4 zp = unpack4(*(const uint2*)(prv + q * 1024));
      if (!has_prev) zp = f32x4{0.f, 0.f, 0.f, 0.f};
      const f32x4 m4 = *(const f32x4*)(mu + q * 1024 + c0);
#pragma unroll
      for (int j = 0; j < 4; ++j) z[q][j] = zc[j] + m4[j] * (zp[j] - zc[j]);
    }
    const f32x4 a = unpack4(*(const uint2*)(apl + (size_t)tok * 1024 + c0));
    const f32x4 kk4 = *(const f32x4*)(k_k + c0);
    const f32x4 ka4 = *(const f32x4*)(k_a + c0);
    f32x4 kk, km, bb;
    float ss = 0.f;
#pragma unroll
    for (int j = 0; j < 4; ++j) { kk[j] = z[1][j] * kk4[j]; ss += kk[j] * kk[j]; }
    ss = reduce16(ss);
    const float inv = 1.f / fmaxf(sqrtf(ss), 1e-12f);
#pragma unroll
    for (int j = 0; j < 4; ++j) {
      kk[j] *= inv;
      km[j] = z[1][j] * (1.f + (a[j] - 1.f) * ka4[j]);
      bb[j] = a[j] * kk[j];
    }
    const size_t o = (size_t)tok * 1024 + c0;
    *(uint2*)(PR + o) = pack4(z[0]);
    *(uint2*)(PK + o) = pack4(km);
    *(uint2*)(PKK + o) = pack4(kk);
    *(uint2*)(PBp + o) = pack4(bb);
    *(uint2*)(PV + o) = pack4(z[2]);
  }
}

__device__ __forceinline__ void phase7(const Params& p, u16* smem) {
  char* ws = p.ws;
  const bool split = gridDim.x >= 512;
  const bool do_conv = split ? (blockIdx.x >= 256) : true;
  const int cbid = split ? (int)blockIdx.x - 256 : (int)blockIdx.x;
  const int cnb = split ? (int)gridDim.x - 256 : (int)gridDim.x;
  if (!do_conv || !split)
  for (int su = blockIdx.x; su < 256; su += gridDim.x) {
    __syncthreads();
    __builtin_amdgcn_s_setprio(3);
  const int tid = opaque_tid(), lane = tid & 63, wid = tid >> 6, l16 = lane & 15, grp = lane >> 4;
  const int bh = su >> 2, rb = (su & 3) * 16;
  const int b = bh >> 4, h = bh & 15;
  const int row = rb + wid * 4 + grp;
  const u16* planes[5] = {(const u16*)(ws + OFF_PR), (const u16*)(ws + OFF_OMD), (const u16*)(ws + OFF_PK),
                          (const u16*)(ws + OFF_PKK), (const u16*)(ws + OFF_PB2)};
  const u16* PV = (const u16*)(ws + OFF_PV);
  u16* yraw = (u16*)(ws + OFF_YRAW);
  float* L = (float*)smem;
  float* LV = L + 32 * 320;
  const int st = tid >> 3, c8 = (tid & 7) * 8;
  const size_t tokb = (size_t)b * 4096;
  uint4 pre[5];
  uint4 prev = make_uint4(0, 0, 0, 0);
  auto issue = [&](int ch) {
    const size_t tok = tokb + ch * 32 + st;
#pragma unroll
    for (int q = 0; q < 5; ++q) pre[q] = *(const uint4*)(planes[q] + tok * 1024 + h * 64 + c8);
    if (tid < 64) prev = *(const uint4*)(PV + (tokb + ch * 32 + (tid >> 1)) * 1024 + h * 64 + rb + (tid & 1) * 8);
  };
  issue(0);
  f32x4 s = f32x4{0.f, 0.f, 0.f, 0.f};
  for (int ch = 0; ch < 128; ++ch) {
    __syncthreads();
#pragma unroll
    for (int q = 0; q < 5; ++q) {
      float* d = L + st * 320 + q * 64 + c8;
      *(f32x4*)d = f32x4{lo2f(pre[q].x), hi2f(pre[q].x), lo2f(pre[q].y), hi2f(pre[q].y)};
      *(f32x4*)(d + 4) = f32x4{lo2f(pre[q].z), hi2f(pre[q].z), lo2f(pre[q].w), hi2f(pre[q].w)};
    }
    if (tid < 64) {
      float* d = LV + (tid >> 1) * 16 + (tid & 1) * 8;
      *(f32x4*)d = f32x4{lo2f(prev.x), hi2f(prev.x), lo2f(prev.y), hi2f(prev.y)};
      *(f32x4*)(d + 4) = f32x4{lo2f(prev.z), hi2f(prev.z), lo2f(prev.w), hi2f(prev.w)};
    }
    __syncthreads();
    if (ch + 1 < 128) issue(ch + 1);
    const float* Lr = L + l16 * 4;
    const float* Lvp = LV + wid * 4 + grp;
    f32x4 kkv = *(const f32x4*)(Lr + 3 * 64);
    float sk = reduce16(s[0] * kkv[0] + s[1] * kkv[1] + s[2] * kkv[2] + s[3] * kkv[3]);
    u16* yp = yraw + (tokb + ch * 32) * 1024 + h * 64 + row;
#pragma unroll
    for (int t = 0; t < 32; ++t) {
      const float* Lt = Lr + t * 320;
      const f32x4 rv = *(const f32x4*)(Lt);
      const f32x4 od = *(const f32x4*)(Lt + 64);
      const f32x4 kv = *(const f32x4*)(Lt + 128);
      const f32x4 bv = *(const f32x4*)(Lt + 256);
      const float vv = Lvp[t * 16];
      const int tn = (t < 31) ? t + 1 : t;
      const f32x4 kkn = *(const f32x4*)(Lr + tn * 320 + 192);
      float py = 0.f, pk = 0.f;
#pragma unroll
      for (int j = 0; j < 4; ++j) {
        float sj = s[j];
        sj = sj - sj * od[j] + vv * kv[j] - sk * bv[j];
        s[j] = sj;
        py += sj * rv[j];
        pk += sj * kkn[j];
      }
      py = reduce16(py);
      pk = reduce16(pk);
      sk = pk;
      yp[t * 1024] = f2bf(py);
    }
  }
    __builtin_amdgcn_s_setprio(0);
  }
  if (do_conv) {
    __syncthreads();
    TJob* jobs = (TJob*)smem;
    float* tile = (float*)((char*)smem + 2048);
    if (threadIdx.x == 0) {
      set_job(jobs[0], p.in[29], (u16*)(ws + OFF_WGT), 2048, 2048, 512, 512, 2048, 32, (long)2048 * 512, (long)512 * 2048);
      set_job(jobs[1], p.in[30], (u16*)(ws + OFF_WUT0), 2048, 2048, 512, 512, 2048, 22, (long)2048 * 512, (long)512 * 2048);
      set_job(jobs[2], p.in[30] + (size_t)22 * 2048 * 512, (u16*)(ws + OFF_WUT1), 2048, 2048, 512, 512, 2048, 10, (long)2048 * 512, (long)512 * 2048);
      set_job(jobs[3], p.in[20], (u16*)(ws + OFF_WBRT), 1024, 1024, 2048, 2048, 1024, 1, 0, 0);
      set_job(jobs[4], p.in[21], (u16*)(ws + OFF_WBMT), 1024, 1024, 2048, 2048, 1024, 1, 0, 0);
      set_job(jobs[5], p.in[22], (u16*)(ws + OFF_WOUTT), 2048, 2048, 2048, 2048, 2048, 1, 0, 0);
      set_job(jobs[6], p.in[32], (u16*)(ws + OFF_WPGT), 2048, 2048, 2048, 2048, 2048, 1, 0, 0);
      set_job(jobs[7], p.in[33], (u16*)(ws + OFF_WPLET), 256, 256, 2048, 2048, 256, 1, 0, 0);
    }
    __syncthreads();
    run_tjobs(jobs, 8, tile, cbid, cnb);
    conv_flat(p.in[1], (u16*)(ws + OFF_PB), (size_t)NTOK * 256, cbid, cnb);
  }
}

__device__ __forceinline__ void phase8(const Params& p) {
  char* ws = p.ws;
  const u16* yraw = (const u16*)(ws + OFF_YRAW);
  const u16* PR = (const u16*)(ws + OFF_PR);
  const u16* PK = (const u16*)(ws + OFF_PK);
  const u16* PV = (const u16*)(ws + OFF_PV);
  const u16* G = (const u16*)(ws + OFF_G);
  u16* __restrict__ yr = (u16*)(ws + OFF_YR);
  const float* r_k = p.in[11];
  const float* lnx_w = p.in[12];
  const float* lnx_b = p.in[13];
  const int gtid = blockIdx.x * NT + opaque_tid(), gsz = gridDim.x * NT;
#pragma unroll 2
  for (int i = gtid; i < NTOK * 256; i += gsz) {
    const int tok = i >> 8, c0 = (i & 255) * 4;
    const size_t o = (size_t)tok * 1024 + c0;
    const f32x4 y = unpack4(*(const uint2*)(yraw + o));
    const float mean = reduce16(y[0] + y[1] + y[2] + y[3]) * (1.f / 64.f);
    float s2 = 0.f;
#pragma unroll
    for (int j = 0; j < 4; ++j) { const float d = y[j] - mean; s2 += d * d; }
    const float rstd = rsqrtf(reduce16(s2) * (1.f / 64.f) + 64e-5f);
    const f32x4 r = unpack4(*(const uint2*)(PR + o));
    const f32x4 k = unpack4(*(const uint2*)(PK + o));
    const f32x4 v = unpack4(*(const uint2*)(PV + o));
    const f32x4 g = unpack4(*(const uint2*)(G + o));
    const f32x4 rk = *(const f32x4*)(r_k + c0);
    const f32x4 lw = *(const f32x4*)(lnx_w + c0);
    const f32x4 lb = *(const f32x4*)(lnx_b + c0);
    float dot = 0.f;
#pragma unroll
    for (int j = 0; j < 4; ++j) dot += r[j] * k[j] * rk[j];
    dot = reduce16(dot);
    f32x4 out;
#pragma unroll
    for (int j = 0; j < 4; ++j) out[j] = ((y[j] - mean) * rstd * lw[j] + lb[j] + dot * v[j]) * g[j];
    *(uint2*)(yr + o) = pack4(out);
  }
}

__device__ __forceinline__ void phase9(const Params& p, u16* smem) {
  char* ws = p.ws;
  const u16* yr = (const u16*)(ws + OFF_YR);
  const u16* ym = (const u16*)(ws + OFF_YM);
  const u16* wbr = (const u16*)(ws + OFF_WBRT);
  const u16* wbm = (const u16*)(ws + OFF_WBMT);
  const u16* ug = (const u16*)(ws + OFF_UG);
  const float* b_gate = p.in[19];
  u16* mixpre = (u16*)(ws + OFF_MIXPRE);
  const int tid = opaque_tid(), lane = tid & 63, wid = tid >> 6;
  const int wr = wid >> 1, wc = wid & 1, fr = lane & 15, fq = lane >> 4;
  const int r = tid >> 3, c = ((tid & 7) ^ ((tid >> 4) & 7)) * 8;
  bool first = true;
  for (int t = blockIdx.x; t < 128 * 16; t += gridDim.x) {
    int tm, tn;
    tile_map(t, 128, 16, tm, tn);
    const int m0 = tm << 7, n0 = tn << 7;
    const int t2 = t + gridDim.x;
    const bool has_next = t2 < 128 * 16;
    int nm0 = m0, nn0 = n0;
    if (has_next) { int tm2, tn2; tile_map(t2, 128, 16, tm2, tn2); nm0 = tm2 << 7; nn0 = tn2 << 7; }
    const u16* ap[4];
    const u16* bp[4];
    const u16* ap2[4];
    const u16* bp2[4];
    const u16* nap[4];
    const u16* nbp[4];
    f32x4 acc[4][4];
#pragma unroll
    for (int m = 0; m < 4; ++m)
#pragma unroll
      for (int n = 0; n < 4; ++n) acc[m][n] = f32x4{0.f, 0.f, 0.f, 0.f};
#pragma unroll
    for (int i = 0; i < 4; ++i) {
      ap[i] = ym + (size_t)(m0 + r + 32 * i) * 1024 + c;
      bp[i] = wbm + (size_t)(n0 + r + 32 * i) * 1024 + c;
      ap2[i] = yr + (size_t)(m0 + r + 32 * i) * 1024 + c;
      bp2[i] = wbr + (size_t)(n0 + r + 32 * i) * 1024 + c;
      nap[i] = ym + (size_t)(nm0 + r + 32 * i) * 1024 + c;
      nbp[i] = wbm + (size_t)(nn0 + r + 32 * i) * 1024 + c;
    }
    mainloop_chain(smem, ap, bp, 16, acc, first, true, ap2, bp2);
    first = false;
    uint2 pm[4][4];
#pragma unroll
    for (int m = 0; m < 4; ++m)
#pragma unroll
      for (int n = 0; n < 4; ++n) { pm[m][n] = pack4(acc[m][n]); acc[m][n] = f32x4{0.f, 0.f, 0.f, 0.f}; }
    mainloop_chain(smem, ap2, bp2, 16, acc, false, has_next, nap, nbp);
#pragma unroll
    for (int m = 0; m < 4; ++m)
#pragma unroll
      for (int n = 0; n < 4; ++n) {
        const int row = m0 + wr * 64 + m * 16 + fr, col = n0 + wc * 64 + n * 16 + fq * 4;
        const f32x4 gr = unpack4(*(const uint2*)(ug + (size_t)row * UG_W + col));
        const f32x4 gm = unpack4(*(const uint2*)(ug + (size_t)row * UG_W + 2048 + col));
        const f32x4 br = *(const f32x4*)(b_gate + col);
        const f32x4 bm = *(const f32x4*)(b_gate + 2048 + col);
        const f32x4 ymv = unpack4(pm[m][n]);
        f32x4 o;
#pragma unroll
        for (int j = 0; j < 4; ++j) o[j] = sigmoidf_(gr[j] + br[j]) * acc[m][n][j] + sigmoidf_(gm[j] + bm[j]) * ymv[j];
        *(uint2*)(mixpre + (size_t)row * 2048 + col) = pack4(o);
      }
  }
}

__device__ __forceinline__ void phase10(const Params& p, u16* smem) {
  char* ws = p.ws;
  const float* x = p.in[0];
  float* h1 = p.out;
  if (blockIdx.x == 0 && threadIdx.x < 32) ((int*)(ws + OFF_CNT))[threadIdx.x] = 0;
  const bool conv_first = blockIdx.x >= (gridDim.x >> 1);
#pragma unroll 1
  for (int pass = 0; pass < 2; ++pass) {
    if ((pass == 0) == conv_first) {
      __syncthreads();
      TJob* jobs = (TJob*)smem;
      float* tile = (float*)((char*)smem + 2048);
      if (threadIdx.x == 0) {
        set_job(jobs[0], p.in[31], (u16*)(ws + OFF_WDT), 512, 512, 2048, 2048, 512, 32, (long)512 * 2048, (long)2048 * 512);
      }
      __syncthreads();
      run_tjobs(jobs, 1, tile, blockIdx.x, gridDim.x);
    } else {
      gemm_plain(smem, (const u16*)(ws + OFF_MIXPRE), 2048, (const u16*)(ws + OFF_WOUTT), 2048, NTOK, 2048, 2048,
                 [=](int row, int col, f32x4 v) {
                   const f32x4 xv = *(const f32x4*)(x + (size_t)row * 2048 + col);
                   f32x4 o;
#pragma unroll
                   for (int j = 0; j < 4; ++j) o[j] = ALPHA_F * xv[j] + v[j];
                   *(f32x4*)(h1 + (size_t)row * 2048 + col) = o;
                 });
    }
  }
}

__device__ __forceinline__ void phase11(const Params& p, u16* smem) {
  char* ws = p.ws;
  const float* h1 = p.out;
  float* x1 = (float*)(ws + OFF_X1);
  u16* x1b = (u16*)(ws + OFF_X1B);
  u16* x1l = (u16*)(ws + OFF_X1L);
  const float* lnw = p.in[23];
  const float* lnb = p.in[24];
  const u16* wrh = (const u16*)(ws + OFF_WRH);
  const u16* wrl = (const u16*)(ws + OFF_WRL);
  const float* b_rg = p.in[26];
  const float* b_re = p.in[28];
  int* list = (int*)(ws + OFF_LIST);
  float* wts = (float*)(ws + OFF_WTS);
  int* cnt = (int*)(ws + OFF_CNT);
  const int tid = opaque_tid(), lane = tid & 63, wid = tid >> 6, fr = lane & 15, fq = lane >> 4;
  float* lgt = (float*)smem;
  for (int grp = blockIdx.x; grp < NTOK / 16; grp += gridDim.x) {
    const int row0 = grp * 16;
    for (int rr = 0; rr < 4; ++rr) {
      const int row = row0 + wid * 4 + rr;
      const float* src = h1 + (size_t)row * 2048;
      f32x4 v[8];
      float s = 0.f;
#pragma unroll
      for (int i = 0; i < 8; ++i) { v[i] = *(const f32x4*)(src + i * 256 + lane * 4); s += v[i][0] + v[i][1] + v[i][2] + v[i][3]; }
      const float mean = wave_sum(s) * (1.f / 2048.f);
      float s2 = 0.f;
#pragma unroll
      for (int i = 0; i < 8; ++i)
#pragma unroll
        for (int j = 0; j < 4; ++j) { const float d = v[i][j] - mean; s2 += d * d; }
      const float rstd = rsqrtf(wave_sum(s2) * (1.f / 2048.f) + 1e-5f);
#pragma unroll
      for (int i = 0; i < 8; ++i) {
        const int col = i * 256 + lane * 4;
        const f32x4 w = *(const f32x4*)(lnw + col);
        const f32x4 bb = *(const f32x4*)(lnb + col);
        f32x4 o, lo;
#pragma unroll
        for (int j = 0; j < 4; ++j) o[j] = (v[i][j] - mean) * rstd * w[j] + bb[j];
        *(f32x4*)(x1 + (size_t)row * 2048 + col) = o;
        const uint2 hb = pack4(o);
        const f32x4 hf = unpack4(hb);
#pragma unroll
        for (int j = 0; j < 4; ++j) lo[j] = o[j] - hf[j];
        *(uint2*)(x1b + (size_t)row * 2048 + col) = hb;
        *(uint2*)(x1l + (size_t)row * 2048 + col) = pack4(lo);
      }
    }
    __syncthreads();
    {
      f32x4 acc[3];
#pragma unroll
      for (int n = 0; n < 3; ++n) acc[n] = f32x4{0.f, 0.f, 0.f, 0.f};
#pragma unroll 2
      for (int ks = 0; ks < 16; ++ks) {
        const int k = wid * 512 + ks * 32 + fq * 8;
        const bf16x8 ah = *(const bf16x8*)(x1b + (size_t)(row0 + fr) * 2048 + k);
        const bf16x8 al = *(const bf16x8*)(x1l + (size_t)(row0 + fr) * 2048 + k);
#pragma unroll
        for (int n = 0; n < 3; ++n) {
          const bf16x8 wh = *(const bf16x8*)(wrh + (size_t)(n * 16 + fr) * 2048 + k);
          const bf16x8 wl = *(const bf16x8*)(wrl + (size_t)(n * 16 + fr) * 2048 + k);
          acc[n] = __builtin_amdgcn_mfma_f32_16x16x32_bf16(wh, ah, acc[n], 0, 0, 0);
          acc[n] = __builtin_amdgcn_mfma_f32_16x16x32_bf16(wl, ah, acc[n], 0, 0, 0);
          acc[n] = __builtin_amdgcn_mfma_f32_16x16x32_bf16(wh, al, acc[n], 0, 0, 0);
        }
      }
      float* part = lgt + 1024 + wid * 768;
#pragma unroll
      for (int n = 0; n < 3; ++n) *(f32x4*)(part + fr * 48 + n * 16 + fq * 4) = acc[n];
    }
    __syncthreads();
    for (int i = tid; i < 768; i += NT) lgt[i] = lgt[1024 + i] + lgt[1024 + 768 + i] + lgt[1024 + 1536 + i] + lgt[1024 + 2304 + i];
    __syncthreads();
    if (tid < 16) {
      const int row = row0 + tid;
      const float* L = lgt + tid * 48;
      float lg[4];
      int gs = 0;
#pragma unroll
      for (int j = 0; j < 4; ++j) lg[j] = L[j] + b_rg[j];
#pragma unroll
      for (int j = 1; j < 4; ++j) if (lg[j] > lg[gs]) gs = j;
      float den = 0.f;
#pragma unroll
      for (int j = 0; j < 4; ++j) den += __expf(lg[j] - lg[gs]);
      const float gw = 1.f / den;
      float le[8];
#pragma unroll
      for (int j = 0; j < 8; ++j) le[j] = L[4 + gs * 8 + j] + b_re[gs * 8 + j];
      int i0 = 0;
#pragma unroll
      for (int j = 1; j < 8; ++j) if (le[j] > le[i0]) i0 = j;
      int i1 = (i0 == 0) ? 1 : 0;
#pragma unroll
      for (int j = 0; j < 8; ++j) if (j != i0 && le[j] > le[i1]) i1 = j;
      const float e1 = __expf(le[i1] - le[i0]);
      const float w0 = gw / (1.f + e1), w1 = gw * e1 / (1.f + e1);
      const int ex0 = gs * 8 + i0, ex1 = gs * 8 + i1;
      const int p0 = atomicAdd(&cnt[ex0], 1);
      list[ex0 * 16384 + p0] = row * 2;
      wts[row * 2] = w0;
      const int p1 = atomicAdd(&cnt[ex1], 1);
      list[ex1 * 16384 + p1] = row * 2 + 1;
      wts[row * 2 + 1] = w1;
    }
    __syncthreads();
  }
}

__device__ __forceinline__ int expert_total(const int* cnt) {
  int acc = 0;
  for (int i = 0; i < 32; ++i) acc += (cnt[i] + 127) >> 7;
  return acc;
}
__device__ __forceinline__ void expert_lookup(const int* cnt, int rbg, int& e, int& rb, int& cnt_e) {
  int acc = 0;
  e = 0; rb = 0; cnt_e = 0;
  for (int i = 0; i < 32; ++i) {
    const int c = cnt[i];
    const int nb = (c + 127) >> 7;
    if (rbg >= acc && rbg < acc + nb) { e = i; rb = rbg - acc; cnt_e = c; }
    acc += nb;
  }
}

__device__ __forceinline__ void phase12(const Params& p, u16* smem) {
  char* ws = p.ws;
  const int* cntg = (const int*)(ws + OFF_CNT);
  const int nrb = expert_total(cntg);
  const int* list = (const int*)(ws + OFF_LIST);
  const u16* x1b = (const u16*)(ws + OFF_X1B);
  const u16* wgt = (const u16*)(ws + OFF_WGT);
  const u16* wut0 = (const u16*)(ws + OFF_WUT0);
  const u16* wut1 = (const u16*)(ws + OFF_WUT1);
  u16* H = (u16*)(ws + OFF_H);
  const int tid = opaque_tid(), lane = tid & 63, wid = tid >> 6;
  const int wr = wid >> 1, wc = wid & 1, fr = lane & 15, fq = lane >> 4;
  const int r = tid >> 3, c = ((tid & 7) ^ ((tid >> 4) & 7)) * 8;
  for (int t = blockIdx.x; t < nrb * 8; t += gridDim.x) {
    const int rbg = t >> 3, hc = t & 7;
    int e, rb, cnt_e;
    expert_lookup(cntg, rbg, e, rb, cnt_e);
    const u16* ap[4];
    const u16* bp[4];
#pragma unroll
    for (int i = 0; i < 4; ++i) {
      const int rr = r + 32 * i;
      const int slot = rb * 128 + rr;
      const int tok = (slot < cnt_e) ? (list[e * 16384 + slot] >> 1) : 0;
      ap[i] = x1b + (size_t)tok * 2048 + c;
      const int sub = rr >> 4, within = rr & 15;
      const int hcol = hc * 64 + (sub >> 1) * 16 + within;
      const u16* ub = (e < 22) ? (wut0 + (size_t)e * 512 * 2048) : (wut1 + (size_t)(e - 22) * 512 * 2048);
      bp[i] = ((sub & 1) ? ub : (wgt + (size_t)e * 512 * 2048)) + (size_t)hcol * 2048 + c;
    }
    f32x4 acc[4][4];
#pragma unroll
    for (int m = 0; m < 4; ++m)
#pragma unroll
      for (int n = 0; n < 4; ++n) acc[m][n] = f32x4{0.f, 0.f, 0.f, 0.f};
    mainloop(smem, ap, bp, 32, acc);
#pragma unroll
    for (int m = 0; m < 4; ++m)
#pragma unroll
      for (int pp = 0; pp < 2; ++pp) {
        const int rowl = wr * 64 + m * 16 + fr;
        const int hcol = hc * 64 + (wc * 2 + pp) * 16 + fq * 4;
        f32x4 o;
#pragma unroll
        for (int j = 0; j < 4; ++j) {
          const float g = acc[m][2 * pp][j], u = acc[m][2 * pp + 1][j];
          o[j] = g * sigmoidf_(g) * u;
        }
        *(uint2*)(H + ((size_t)rbg * 128 + rowl) * 512 + hcol) = pack4(o);
      }
  }
}

__device__ __forceinline__ void phase13(const Params& p, u16* smem) {
  char* ws = p.ws;
  const int* cntg = (const int*)(ws + OFF_CNT);
  const int nrb = expert_total(cntg);
  const int* list = (const int*)(ws + OFF_LIST);
  const float* wts = (const float*)(ws + OFF_WTS);
  const u16* H = (const u16*)(ws + OFF_H);
  const u16* wdt = (const u16*)(ws + OFF_WDT);
  u16* moey = (u16*)(ws + OFF_MOEY);
  const int tid = opaque_tid(), lane = tid & 63, wid = tid >> 6;
  const int wr = wid >> 1, wc = wid & 1, fr = lane & 15, fq = lane >> 4;
  const int r = tid >> 3, c = ((tid & 7) ^ ((tid >> 4) & 7)) * 8;
  for (int t = blockIdx.x; t < nrb * 16; t += gridDim.x) {
    const int rbg = t >> 4, nc = t & 15;
    int e, rb, cnt_e;
    expert_lookup(cntg, rbg, e, rb, cnt_e);
    const u16* ap[4];
    const u16* bp[4];
#pragma unroll
    for (int i = 0; i < 4; ++i) {
      ap[i] = H + ((size_t)rbg * 128 + r + 32 * i) * 512 + c;
      bp[i] = wdt + ((size_t)e * 2048 + nc * 128 + r + 32 * i) * 512 + c;
    }
    f32x4 acc[4][4];
#pragma unroll
    for (int m = 0; m < 4; ++m)
#pragma unroll
      for (int n = 0; n < 4; ++n) acc[m][n] = f32x4{0.f, 0.f, 0.f, 0.f};
    mainloop(smem, ap, bp, 8, acc);
#pragma unroll
    for (int m = 0; m < 4; ++m) {
      const int slot = rb * 128 + wr * 64 + m * 16 + fr;
      if (slot < cnt_e) {
        const int entry = list[e * 16384 + slot];
        const float w = wts[entry];
#pragma unroll
        for (int n = 0; n < 4; ++n) {
          f32x4 o;
#pragma unroll
          for (int j = 0; j < 4; ++j) o[j] = acc[m][n][j] * w;
          *(uint2*)(moey + (size_t)entry * 2048 + nc * 128 + wc * 64 + n * 16 + fq * 4) = pack4(o);
        }
      }
    }
  }
  const u16* x1b = (const u16*)(ws + OFF_X1B);
  const u16* pb = (const u16*)(ws + OFF_PB);
  const u16* wpg = (const u16*)(ws + OFF_WPGT);
  const u16* wple = (const u16*)(ws + OFF_WPLET);
  const float* x1 = (const float*)(ws + OFF_X1);
  float* h2 = p.out;
  bool first = true;
  for (int t = blockIdx.x; t < 128 * 16; t += gridDim.x) {
    int tm, tn;
    tile_map(t, 128, 16, tm, tn);
    const int m0 = tm << 7, n0 = tn << 7;
    const int t2 = t + gridDim.x;
    const bool has_next = t2 < 128 * 16;
    int nm0 = m0, nn0 = n0;
    if (has_next) { int tm2, tn2; tile_map(t2, 128, 16, tm2, tn2); nm0 = tm2 << 7; nn0 = tn2 << 7; }
    const u16* ap[4];
    const u16* bp[4];
    const u16* ap2[4];
    const u16* bp2[4];
    const u16* nap[4];
    const u16* nbp[4];
    f32x4 acc[4][4];
#pragma unroll
    for (int m = 0; m < 4; ++m)
#pragma unroll
      for (int n = 0; n < 4; ++n) acc[m][n] = f32x4{0.f, 0.f, 0.f, 0.f};
#pragma unroll
    for (int i = 0; i < 4; ++i) {
      ap[i] = pb + (size_t)(m0 + r + 32 * i) * 256 + c;
      bp[i] = wple + (size_t)(n0 + r + 32 * i) * 256 + c;
      ap2[i] = x1b + (size_t)(m0 + r + 32 * i) * 2048 + c;
      bp2[i] = wpg + (size_t)(n0 + r + 32 * i) * 2048 + c;
      nap[i] = pb + (size_t)(nm0 + r + 32 * i) * 256 + c;
      nbp[i] = wple + (size_t)(nn0 + r + 32 * i) * 256 + c;
    }
    mainloop_chain(smem, ap, bp, 4, acc, first, true, ap2, bp2);
    first = false;
    uint2 ple[4][4];
#pragma unroll
    for (int m = 0; m < 4; ++m)
#pragma unroll
      for (int n = 0; n < 4; ++n) { ple[m][n] = pack4(acc[m][n]); acc[m][n] = f32x4{0.f, 0.f, 0.f, 0.f}; }
    mainloop_chain(smem, ap2, bp2, 32, acc, false, has_next, nap, nbp);
#pragma unroll
    for (int m = 0; m < 4; ++m)
#pragma unroll
      for (int n = 0; n < 4; ++n) {
        const int row = m0 + wr * 64 + m * 16 + fr, col = n0 + wc * 64 + n * 16 + fq * 4;
        const f32x4 xv = *(const f32x4*)(x1 + (size_t)row * 2048 + col);
        const f32x4 pl = unpack4(ple[m][n]);
        f32x4 o;
#pragma unroll
        for (int j = 0; j < 4; ++j) o[j] = ALPHA_F * xv[j] + sigmoidf_(acc[m][n][j]) * pl[j];
        *(f32x4*)(h2 + (size_t)row * 2048 + col) = o;
      }
  }
}

__device__ __forceinline__ void phase14(const Params& p) {
  char* ws = p.ws;
  float* out = p.out;
  const u16* moey = (const u16*)(ws + OFF_MOEY);
  const float* lnw = p.in[34];
  const float* lnb = p.in[35];
  const int lane = opaque_tid() & 63;
  const int gw = (blockIdx.x * NT + opaque_tid()) >> 6, nw = (gridDim.x * NT) >> 6;
  for (int row = gw; row < NTOK; row += nw) {
    float* src = out + (size_t)row * 2048;
    f32x4 v[8];
    float s = 0.f;
#pragma unroll
    for (int i = 0; i < 8; ++i) {
      const int col = i * 256 + lane * 4;
      v[i] = *(const f32x4*)(src + col);
      const f32x4 m0 = unpack4(*(const uint2*)(moey + (size_t)(row * 2) * 2048 + col));
      const f32x4 m1 = unpack4(*(const uint2*)(moey + (size_t)(row * 2 + 1) * 2048 + col));
#pragma unroll
      for (int j = 0; j < 4; ++j) { v[i][j] += m0[j] + m1[j]; s += v[i][j]; }
    }
    const float mean = wave_sum(s) * (1.f / 2048.f);
    float s2 = 0.f;
#pragma unroll
    for (int i = 0; i < 8; ++i)
#pragma unroll
      for (int j = 0; j < 4; ++j) { const float d = v[i][j] - mean; s2 += d * d; }
    const float rstd = rsqrtf(wave_sum(s2) * (1.f / 2048.f) + 1e-5f);
#pragma unroll
    for (int i = 0; i < 8; ++i) {
      const int col = i * 256 + lane * 4;
      const f32x4 w = *(const f32x4*)(lnw + col);
      const f32x4 bb = *(const f32x4*)(lnb + col);
      f32x4 o;
#pragma unroll
      for (int j = 0; j < 4; ++j) o[j] = (v[i][j] - mean) * rstd * w[j] + bb[j];
      *(f32x4*)(src + col) = o;
    }
  }
}


#define XB_TMO      128
#define XB_XCNT(j)  (256  + 64 * (j))
#define XB_XSUB(j)  (1280 + 64 * (j))
#define XB_XGEN(j)  (2304 + 64 * (j))
#define XB_TOP      3328
#define XB_TOPGEN   3392
#define XCD_BAR_WORDS 3456
#define XB_SPIN_CAP (1u << 22)
__device__ __forceinline__ unsigned xb_ld(unsigned* p) { return __hip_atomic_load(p, __ATOMIC_RELAXED, __HIP_MEMORY_SCOPE_AGENT); }
__device__ __forceinline__ unsigned xb_add(unsigned* p, unsigned v) { return __hip_atomic_fetch_add(p, v, __ATOMIC_RELAXED, __HIP_MEMORY_SCOPE_AGENT); }
__device__ __forceinline__ unsigned xb_xcc_id() { return (unsigned)__builtin_amdgcn_s_getreg((3 << 11) | 20) & 0xFu; }
#define XB_SPIN(cond, bar) do { unsigned _sp = 0; while (cond) { __builtin_amdgcn_s_sleep(1); \
    if ((++_sp & 255u) == 0u) { if (xb_ld(&(bar)[XB_TMO])) break; if (_sp > XB_SPIN_CAP) { atomicAdd(&(bar)[XB_TMO], 1u); break; } } } } while (0)
struct XcdBarrier { unsigned* bar; unsigned x, nloc, nx; };
__device__ __forceinline__ void xcd_barrier(const XcdBarrier& b) {
  asm volatile("s_waitcnt vmcnt(0)" ::: "memory");
  __syncthreads();
  if (threadIdx.x == 0) {
    unsigned* bar = b.bar;
    __builtin_amdgcn_s_waitcnt(0);
    const unsigned nloc = b.nloc, nx = b.nx;
    const unsigned old = xb_add(&bar[XB_XSUB(b.x)], 1u);
    const unsigned gen = old / nloc;
    if (old + 1u == (gen + 1u) * nloc) {
      __builtin_amdgcn_fence(__ATOMIC_RELEASE, "agent");
      asm volatile("s_waitcnt vmcnt(0)" ::: "memory");
      const unsigned og = xb_add(&bar[XB_TOP], 1u);
      const unsigned tg = og / nx;
      if (og + 1u == (tg + 1u) * nx) xb_add(&bar[XB_TOPGEN], 1u);
      else XB_SPIN(xb_ld(&bar[XB_TOPGEN]) == tg, bar);
      __builtin_amdgcn_fence(__ATOMIC_ACQUIRE, "agent");
      xb_add(&bar[XB_XGEN(b.x)], 1u);
      asm volatile("s_waitcnt vmcnt(0)" ::: "memory");
    } else {
      XB_SPIN(xb_ld(&bar[XB_XGEN(b.x)]) == gen, bar);
      __builtin_amdgcn_fence(__ATOMIC_ACQUIRE, "agent");
      asm volatile("s_waitcnt vmcnt(0)" ::: "memory");
    }
  }
  __syncthreads();
}

#ifndef LASTP
#define LASTP 14
#endif
__global__ void __launch_bounds__(NT, 2) fwd_megakernel(Params p) {
  __shared__ __attribute__((aligned(16))) u16 smem[32768];
  cg::grid_group grid = cg::this_grid();
  XcdBarrier xb;
  xb.bar = (unsigned*)(p.ws + OFF_BAR);
  xb.x = xb_xcc_id();
  xb.nloc = 1u; xb.nx = 1u;
  if (threadIdx.x == 0) (void)xb_add(&xb.bar[XB_XCNT(xb.x)], 1u);
  phase0(p, (char*)smem);
  if (LASTP < 1) return;
  if (p.out == nullptr) grid.sync();
  __syncthreads();
  if (threadIdx.x == 0) {
    const unsigned G = gridDim.x;
    unsigned sum, cntx, mine, sp = 0u;
    for (;;) {
      sum = 0u; cntx = 0u; mine = 0u;
#pragma unroll
      for (unsigned j = 0; j < 16; ++j) {
        const unsigned c = xb_ld(&xb.bar[XB_XCNT(j)]);
        sum += c; cntx += (c > 0u) ? 1u : 0u; mine = (j == xb.x) ? c : mine;
      }
      if (sum == G) break;
      __builtin_amdgcn_s_sleep(1);
      if (++sp > XB_SPIN_CAP) break;
    }
    ((unsigned*)smem)[0] = mine > 0u ? mine : 1u;
    ((unsigned*)smem)[1] = cntx > 0u ? cntx : 1u;
  }
  __syncthreads();
  xb.nloc = (unsigned)__builtin_amdgcn_readfirstlane((int)((unsigned*)smem)[0]);
  xb.nx = (unsigned)__builtin_amdgcn_readfirstlane((int)((unsigned*)smem)[1]);
  xcd_barrier(xb);
  phase1(p, smem);
  if (LASTP < 2) return;
  xcd_barrier(xb);
  phase2(p, smem);
  if (LASTP < 3) return;
  xcd_barrier(xb);
  phase3(p, smem);
  if (LASTP < 4) return;
  xcd_barrier(xb);
  phase4(p);
  if (LASTP < 5) return;
  xcd_barrier(xb);
  phase5(p, smem);
  if (LASTP < 6) return;
  xcd_barrier(xb);
  phase6(p);
  if (LASTP < 7) return;
  xcd_barrier(xb);
  phase7(p, smem);
  if (LASTP < 8) return;
  xcd_barrier(xb);
  phase8(p);
  if (LASTP < 9) return;
  xcd_barrier(xb);
  phase9(p, smem);
  if (LASTP < 10) return;
  xcd_barrier(xb);
  phase10(p, smem);
  if (LASTP < 11) return;
  xcd_barrier(xb);
  phase11(p, smem);
  if (LASTP < 12) return;
  xcd_barrier(xb);
  phase12(p, smem);
  if (LASTP < 13) return;
  xcd_barrier(xb);
  phase13(p, smem);
  if (LASTP < 14) return;
  xcd_barrier(xb);
  phase14(p);
}

extern "C" void kernel_launch(void* const* d_in, const int* in_sizes, int n_in, void* d_out, int out_size, void* d_ws,
                              size_t ws_size, hipStream_t stream) {
  static int grid_blocks = 0;
  if (!grid_blocks) {
    int dev = 0, cus = 0, per_cu = 0;
    hipGetDevice(&dev);
    hipDeviceGetAttribute(&cus, hipDeviceAttributeMultiprocessorCount, dev);
    hipOccupancyMaxActiveBlocksPerMultiprocessor(&per_cu, fwd_megakernel, NT, 0);
    if (per_cu > 2) per_cu = 2;
    grid_blocks = cus * per_cu;
  }
  if (ws_size < WS_NEED || n_in < 36) {
    fprintf(stderr, "workspace too small: %zu < %zu\n", ws_size, (size_t)WS_NEED);
    return;
  }
  Params p{};
  for (int i = 0; i < 36; ++i) p.in[i] = (const float*)d_in[i];
  p.out = (float*)d_out;
  p.ws = (char*)d_ws;
  (void)hipMemsetAsync((char*)d_ws + OFF_BAR, 0, 16384, stream);
  void* args[] = {&p};
  hipError_t e = hipLaunchCooperativeKernel((void*)fwd_megakernel, dim3(grid_blocks), dim3(NT), args, 0, stream);
  if (e != hipSuccess) fprintf(stderr, "cooperative launch failed: %s (grid %d)\n", hipGetErrorString(e), grid_blocks);
}
```

```cpp
#include <hip/hip_runtime.h>
#include <hip/hip_cooperative_groups.h>
#include <cstdio>
namespace cg = cooperative_groups;

typedef unsigned short u16;
using bf16x8 = __attribute__((ext_vector_type(8))) short;
using f32x4 = __attribute__((ext_vector_type(4))) float;
using f32x2 = __attribute__((ext_vector_type(2))) float;

constexpr int NT = 256;
constexpr int NTOK = 16384, DM = 2048, SEQ = 4096;
constexpr int UR_W = 3456, UM_W = 3200, UG_W = 4096;
constexpr float ALPHA_F = 1.189207115002721f;

constexpr size_t SZ_UR = (size_t)NTOK * UR_W * 2;
constexpr size_t SZ_UM = (size_t)NTOK * UM_W * 2;
constexpr size_t SZ_UG = (size_t)NTOK * UG_W * 2;
constexpr size_t SZ_XB = (size_t)NTOK * DM * 2;
constexpr size_t SZ_WINT = (size_t)10752 * 2048 * 2;
constexpr size_t SZ_PL = (size_t)NTOK * 1024 * 2;
constexpr size_t OFF_R0 = 0;
constexpr size_t OFF_R1 = OFF_R0 + SZ_UR;
constexpr size_t OFF_R2 = OFF_R1 + SZ_UM;
constexpr size_t OFF_R3 = OFF_R2 + SZ_UG;
constexpr size_t OFF_R4 = OFF_R3 + SZ_XB;
constexpr size_t OFF_R5 = OFF_R4 + SZ_WINT;
constexpr size_t OFF_WBRT = OFF_R5;
constexpr size_t OFF_WBMT = OFF_WBRT + (size_t)2048 * 1024 * 2;
constexpr size_t OFF_WOUTT = OFF_WBMT + (size_t)2048 * 1024 * 2;
constexpr size_t OFF_WPGT = OFF_WOUTT + (size_t)2048 * 2048 * 2;
constexpr size_t OFF_WPLET = OFF_WPGT + (size_t)2048 * 2048 * 2;
constexpr size_t OFF_WW2T = OFF_WPLET + (size_t)2048 * 256 * 2;
constexpr size_t OFF_WA2T = OFF_WW2T + (size_t)1024 * 64 * 2;
constexpr size_t OFF_WG2T = OFF_WA2T + (size_t)1024 * 64 * 2;
constexpr size_t OFF_PB = OFF_WG2T + (size_t)1024 * 192 * 2;
constexpr size_t OFF_WRH = OFF_PB + (size_t)NTOK * 256 * 2;
constexpr size_t OFF_WRL = OFF_WRH + (size_t)48 * 2048 * 2;
constexpr size_t OFF_FREE = OFF_WRL + (size_t)48 * 2048 * 2;
constexpr size_t OFF_UR = OFF_R0, OFF_UM = OFF_R1, OFF_UG = OFF_R2, OFF_XB = OFF_R3, OFF_WINT = OFF_R4;
constexpr size_t OFF_QC = OFF_R3;
constexpr size_t OFF_KC = OFF_QC + (size_t)NTOK * 512 * 2;
constexpr size_t OFF_KT = OFF_KC + (size_t)NTOK * 512 * 2;
constexpr size_t OFF_MISC = OFF_KT + (size_t)NTOK * 512 * 2;
constexpr size_t OFF_IPRE = OFF_MISC;
constexpr size_t OFF_LOGF = OFF_IPRE + (size_t)32 * 4096 * 4;
constexpr size_t OFF_ATOT = OFF_LOGF + (size_t)32 * 4096 * 4;
constexpr size_t OFF_GLMX = OFF_ATOT + 4096;
constexpr size_t OFF_MST = OFF_GLMX + 4096;
constexpr size_t OFF_DN = OFF_MST + 4096;
constexpr size_t OFF_VT = OFF_R4;
constexpr size_t OFF_LW = OFF_R4 + SZ_PL;
constexpr size_t OFF_LA = OFF_LW + (size_t)NTOK * 64 * 2;
constexpr size_t OFF_LG = OFF_LA + (size_t)NTOK * 64 * 2;
constexpr size_t OFF_YM = OFF_FREE;
constexpr size_t OFF_OMD = OFF_YM + SZ_PL;
constexpr size_t OFF_APL = OFF_OMD + SZ_PL;
constexpr size_t OFF_YR = OFF_APL;
constexpr size_t OFF_G = OFF_APL + SZ_PL;
constexpr size_t OFF_DC = OFF_G + SZ_PL;
constexpr size_t OFF_YRAW = OFF_DC;
constexpr size_t OFF_PR = OFF_R1;
constexpr size_t OFF_PK = OFF_PR + SZ_PL;
constexpr size_t OFF_PKK = OFF_PK + SZ_PL;
constexpr size_t OFF_PB2 = OFF_R3;
constexpr size_t OFF_PV = OFF_PB2 + SZ_PL;
constexpr size_t OFF_MIXPRE = OFF_R3;
constexpr size_t OFF_WGT = OFF_R0;
constexpr size_t OFF_WUT0 = OFF_WGT + (size_t)32 * 512 * 2048 * 2;
constexpr size_t OFF_WUT1 = OFF_R4 + ((size_t)4 << 20);
constexpr size_t OFF_WDT = OFF_R1;
constexpr size_t OFF_X1 = OFF_R2;
constexpr size_t OFF_X1B = OFF_R3;
constexpr size_t OFF_LIST = OFF_R4;
constexpr size_t OFF_WTS = OFF_LIST + (size_t)32 * 16384 * 4;
constexpr size_t OFF_CNT = OFF_WTS + (size_t)32768 * 4;
constexpr size_t OFF_H = OFF_FREE;
constexpr size_t OFF_MOEY = OFF_H + (size_t)36864 * 512 * 2;
constexpr size_t OFF_X1L = OFF_MOEY;
constexpr size_t OFF_BAR = OFF_MOEY + (size_t)32768 * 2048 * 2;
constexpr size_t WS_NEED = OFF_BAR + 16384;
static_assert(OFF_DC + (size_t)1024 * 128 * 64 * 4 <= WS_NEED, "ws");
static_assert(OFF_WUT0 + (size_t)22 * 512 * 2048 * 2 <= OFF_R1, "up0 fit");
static_assert(OFF_WUT1 + (size_t)10 * 512 * 2048 * 2 <= OFF_R5, "up1 fit");
static_assert(OFF_WDT + (size_t)32 * 512 * 2048 * 2 <= OFF_R2, "down fit");
static_assert(OFF_CNT + 128 <= OFF_WUT1, "lists fit");
static_assert(OFF_DN + 1024 * 64 * 4 <= OFF_R4, "misc fit");
static_assert(OFF_LG + (size_t)NTOK * 192 * 2 <= OFF_R5, "lora fit");
static_assert(OFF_PKK + SZ_PL <= OFF_R2, "planes fit");

struct Params {
  const float* in[36];
  float* out;
  char* ws;
};

__device__ __forceinline__ u16 f2bf(float f) { return __builtin_bit_cast(u16, (__bf16)f); }
__device__ __forceinline__ float bf2f(u16 h) { return __uint_as_float(((unsigned)h) << 16); }
typedef __bf16 bf16x2_t __attribute__((ext_vector_type(2)));
__device__ __forceinline__ unsigned pack2(float a, float b) {
  f32x2 v = {a, b};
  return __builtin_bit_cast(unsigned, __builtin_convertvector(v, bf16x2_t));
}
__device__ __forceinline__ float lo2f(unsigned u) { return __uint_as_float(u << 16); }
__device__ __forceinline__ float hi2f(unsigned u) { return __uint_as_float(u & 0xffff0000u); }
__device__ __forceinline__ float sigmoidf_(float x) { return __builtin_amdgcn_rcpf(1.f + __expf(-x)); }
__device__ __forceinline__ uint2 pack4(f32x4 v) { return make_uint2(pack2(v[0], v[1]), pack2(v[2], v[3])); }
__device__ __forceinline__ f32x4 unpack4(uint2 u) {
  f32x4 r; r[0] = lo2f(u.x); r[1] = hi2f(u.x); r[2] = lo2f(u.y); r[3] = hi2f(u.y); return r;
}
__device__ __forceinline__ int opaque_tid() {
  int t = threadIdx.x;
  asm volatile("" : "+v"(t));
  return t;
}
template <int CTRL>
__device__ __forceinline__ float dpp_add(float v) {
  int x = __builtin_amdgcn_update_dpp(0, __float_as_int(v), CTRL, 0xf, 0xf, true);
  return v + __int_as_float(x);
}
__device__ __forceinline__ float reduce16(float v) {
  v = dpp_add<0xB1>(v);
  v = dpp_add<0x4E>(v);
  v = dpp_add<0x141>(v);
  v = dpp_add<0x140>(v);
  return v;
}
__device__ __forceinline__ float wave_sum(float v) {
#pragma unroll
  for (int o = 32; o > 0; o >>= 1) v += __shfl_xor(v, o);
  return v;
}

template <typename T>
__device__ __forceinline__ T ldu(const void* ubase, unsigned voff) { return *(const T*)((const char*)ubase + voff); }
template <typename T>
__device__ __forceinline__ void stu(void* ubase, unsigned voff, T v) { *(T*)((char*)ubase + voff) = v; }

#define GLDS16(g, l) __builtin_amdgcn_global_load_lds((const unsigned*)(g), (unsigned*)(l), 16, 0, 0)

__device__ __forceinline__ void mainloop(u16* smem, const u16* (&ap)[4], const u16* (&bp)[4], int nk,
                                         f32x4 (&acc)[4][4]) {
  const int tid = opaque_tid(), lane = tid & 63, wid = tid >> 6;
  const int wr = wid >> 1, wc = wid & 1, fr = lane & 15, fq = lane >> 4;
  u16* sA = smem;
  u16* sB = smem + 16384;
  __syncthreads();
#pragma unroll
  for (int i = 0; i < 4; ++i) {
    GLDS16(ap[i], sA + (tid + i * 256) * 8);
    GLDS16(bp[i], sB + (tid + i * 256) * 8);
  }
  const int sw = fr >> 1;
  for (int kt = 0; kt < nk; ++kt) {
    asm volatile("s_waitcnt vmcnt(0)" ::: "memory");
    __syncthreads();
    const int buf = kt & 1;
    if (kt + 1 < nk) {
      const int ko = (kt + 1) * 64;
      u16* dA = sA + (buf ^ 1) * 8192;
      u16* dB = sB + (buf ^ 1) * 8192;
#pragma unroll
      for (int i = 0; i < 4; ++i) {
        GLDS16(ap[i] + ko, dA + (tid + i * 256) * 8);
        GLDS16(bp[i] + ko, dB + (tid + i * 256) * 8);
      }
    }
    const u16* cA = sA + buf * 8192 + (wr * 64 + fr) * 64;
    const u16* cB = sB + buf * 8192 + (wc * 64 + fr) * 64;
#pragma unroll
    for (int kk = 0; kk < 2; ++kk) {
      bf16x8 af[4], bfr[4];
      const int ch = ((kk * 4 + fq) ^ sw) * 8;
#pragma unroll
      for (int m = 0; m < 4; ++m) af[m] = *(const bf16x8*)(cA + m * 1024 + ch);
#pragma unroll
      for (int n = 0; n < 4; ++n) bfr[n] = *(const bf16x8*)(cB + n * 1024 + ch);
#pragma unroll
      for (int m = 0; m < 4; ++m)
#pragma unroll
        for (int n = 0; n < 4; ++n)
          acc[m][n] = __builtin_amdgcn_mfma_f32_16x16x32_bf16(bfr[n], af[m], acc[m][n], 0, 0, 0);
    }
  }
}


__device__ __forceinline__ void mainloop_chain(u16* smem, const u16* (&ap)[4], const u16* (&bp)[4], int nk,
                                               f32x4 (&acc)[4][4], bool first, bool has_next,
                                               const u16* (&nap)[4], const u16* (&nbp)[4]) {
  const int tid = opaque_tid(), lane = tid & 63, wid = tid >> 6;
  const int wr = wid >> 1, wc = wid & 1, fr = lane & 15, fq = lane >> 4;
  u16* sA = smem;
  u16* sB = smem + 16384;
  if (first) {
    __syncthreads();
#pragma unroll
    for (int i = 0; i < 4; ++i) {
      GLDS16(ap[i], sA + (tid + i * 256) * 8);
      GLDS16(bp[i], sB + (tid + i * 256) * 8);
    }
  }
  const int sw = fr >> 1;
  for (int kt = 0; kt < nk; ++kt) {
    asm volatile("s_waitcnt vmcnt(0)" ::: "memory");
    __syncthreads();
    const int buf = kt & 1;
    u16* dA = sA + (buf ^ 1) * 8192;
    u16* dB = sB + (buf ^ 1) * 8192;
    if (kt + 1 < nk) {
      const int ko = (kt + 1) * 64;
#pragma unroll
      for (int i = 0; i < 4; ++i) {
        GLDS16(ap[i] + ko, dA + (tid + i * 256) * 8);
        GLDS16(bp[i] + ko, dB + (tid + i * 256) * 8);
      }
    } else if (has_next) {
#pragma unroll
      for (int i = 0; i < 4; ++i) {
        GLDS16(nap[i], dA + (tid + i * 256) * 8);
        GLDS16(nbp[i], dB + (tid + i * 256) * 8);
      }
    }
    __builtin_amdgcn_sched_barrier(0);
    const u16* cA = sA + buf * 8192 + (wr * 64 + fr) * 64;
    const u16* cB = sB + buf * 8192 + (wc * 64 + fr) * 64;
#pragma unroll
    for (int kk = 0; kk < 2; ++kk) {
      bf16x8 af[4], bfr[4];
      const int ch = ((kk * 4 + fq) ^ sw) * 8;
#pragma unroll
      for (int m = 0; m < 4; ++m) af[m] = *(const bf16x8*)(cA + m * 1024 + ch);
#pragma unroll
      for (int n = 0; n < 4; ++n) bfr[n] = *(const bf16x8*)(cB + n * 1024 + ch);
      __builtin_amdgcn_s_setprio(1);
#pragma unroll
      for (int m = 0; m < 4; ++m)
#pragma unroll
        for (int n = 0; n < 4; ++n)
          acc[m][n] = __builtin_amdgcn_mfma_f32_16x16x32_bf16(bfr[n], af[m], acc[m][n], 0, 0, 0);
      __builtin_amdgcn_s_setprio(0);
    }
  }
}


__device__ __forceinline__ void mainloop_rs(u16* smem, const u16* (&ap)[4], const u16* (&bp)[4], int nk,
                                            f32x4 (&acc)[4][4]) {
  const int tid = opaque_tid(), lane = tid & 63, wid = tid >> 6;
  const int wr = wid >> 1, wc = wid & 1, fr = lane & 15, fq = lane >> 4;
  u16* sA = smem;
  u16* sB = smem + 16384;
  const int sw = fr >> 1;
  uint4 ra00, ra01, ra02, ra03, rb00, rb01, rb02, rb03, ra10, ra11, ra12, ra13, rb10, rb11, rb12, rb13;
#define RS_LD(S, KT)                                  \
  {                                                   \
    const int ko_ = (KT) * 64;                        \
    ra##S##0 = *(const uint4*)(ap[0] + ko_);          \
    rb##S##0 = *(const uint4*)(bp[0] + ko_);          \
    ra##S##1 = *(const uint4*)(ap[1] + ko_);          \
    rb##S##1 = *(const uint4*)(bp[1] + ko_);          \
    ra##S##2 = *(const uint4*)(ap[2] + ko_);          \
    rb##S##2 = *(const uint4*)(bp[2] + ko_);          \
    ra##S##3 = *(const uint4*)(ap[3] + ko_);          \
    rb##S##3 = *(const uint4*)(bp[3] + ko_);          \
  }
#define RS_ST(S, BUF)                                              \
  {                                                                \
    *(uint4*)(sA + (BUF) * 8192 + (tid + 0 * 256) * 8) = ra##S##0; \
    *(uint4*)(sB + (BUF) * 8192 + (tid + 0 * 256) * 8) = rb##S##0; \
    *(uint4*)(sA + (BUF) * 8192 + (tid + 1 * 256) * 8) = ra##S##1; \
    *(uint4*)(sB + (BUF) * 8192 + (tid + 1 * 256) * 8) = rb##S##1; \
    *(uint4*)(sA + (BUF) * 8192 + (tid + 2 * 256) * 8) = ra##S##2; \
    *(uint4*)(sB + (BUF) * 8192 + (tid + 2 * 256) * 8) = rb##S##2; \
    *(uint4*)(sA + (BUF) * 8192 + (tid + 3 * 256) * 8) = ra##S##3; \
    *(uint4*)(sB + (BUF) * 8192 + (tid + 3 * 256) * 8) = rb##S##3; \
  }
#define RS_COMPUTE(BUF)                                                                            \
  {                                                                                                \
    const u16* cA = sA + (BUF) * 8192 + (wr * 64 + fr) * 64;                                       \
    const u16* cB = sB + (BUF) * 8192 + (wc * 64 + fr) * 64;                                       \
    _Pragma("unroll") for (int kk = 0; kk < 2; ++kk) {                                             \
      bf16x8 af[4], bfr[4];                                                                        \
      const int ch = ((kk * 4 + fq) ^ sw) * 8;                                                     \
      _Pragma("unroll") for (int m = 0; m < 4; ++m) af[m] = *(const bf16x8*)(cA + m * 1024 + ch);  \
      _Pragma("unroll") for (int n = 0; n < 4; ++n) bfr[n] = *(const bf16x8*)(cB + n * 1024 + ch); \
      _Pragma("unroll") for (int m = 0; m < 4; ++m)                                                \
        _Pragma("unroll") for (int n = 0; n < 4; ++n)                                              \
          acc[m][n] = __builtin_amdgcn_mfma_f32_16x16x32_bf16(bfr[n], af[m], acc[m][n], 0, 0, 0);  \
    }                                                                                              \
  }
  __syncthreads();
  RS_LD(0, 0);
  RS_LD(1, min(1, nk - 1));
  RS_ST(0, 0);
  RS_LD(0, min(2, nk - 1));
  __syncthreads();
  for (int kt = 0; kt < nk; kt += 2) {
    RS_ST(1, 1);
    RS_LD(1, min(kt + 3, nk - 1));
    RS_COMPUTE(0);
    __syncthreads();
    if (kt + 1 < nk) {
      RS_ST(0, 0);
      RS_LD(0, min(kt + 4, nk - 1));
      RS_COMPUTE(1);
      __syncthreads();
    }
  }
#undef RS_LD
#undef RS_ST
#undef RS_COMPUTE
}

__device__ __forceinline__ void tile_map(int t, int ntm, int ntn, int& tm, int& tn) {
  const int nt = ntm * ntn;
  const int q = nt >> 3, r = nt & 7, xcd = t & 7, off = t >> 3;
  const int t2 = (xcd < r ? xcd * (q + 1) : r * (q + 1) + (xcd - r) * q) + off;
  const int nig = 8 * ntn;
  const int gid = t2 / nig, fm = gid * 8;
  const int gsz = min(ntm - fm, 8);
  tm = fm + (t2 % nig) % gsz;
  tn = (t2 % nig) / gsz;
}

template <class Epi>
__device__ __forceinline__ void gemm_plain(u16* smem, const u16* A, int lda, const u16* Bt, int ldb, int M, int N,
                                           int K, Epi epi) {
  const int ntm = M >> 7, ntn = N >> 7, ntiles = ntm * ntn, nk = K >> 6;
  const int tid = opaque_tid(), lane = tid & 63, wid = tid >> 6;
  const int wr = wid >> 1, wc = wid & 1, fr = lane & 15, fq = lane >> 4;
  const int r = tid >> 3, c = ((tid & 7) ^ ((tid >> 4) & 7)) * 8;
  const bool chain = (nk & 1) == 0;
  int t = blockIdx.x;
  if (t >= ntiles) return;
  int tm, tn;
  tile_map(t, ntm, ntn, tm, tn);
  int m0 = tm << 7, n0 = tn << 7;
  const u16* ap[4];
  const u16* bp[4];
#pragma unroll
  for (int i = 0; i < 4; ++i) {
    ap[i] = A + (size_t)(m0 + r + 32 * i) * lda + c;
    bp[i] = Bt + (size_t)(n0 + r + 32 * i) * ldb + c;
  }
  bool first = true;
  for (; t < ntiles; t += gridDim.x) {
    const int t2 = t + gridDim.x;
    const bool has_next = chain && (t2 < ntiles);
    int nm0 = m0, nn0 = n0;
    if (t2 < ntiles) {
      int tm2, tn2;
      tile_map(t2, ntm, ntn, tm2, tn2);
      nm0 = tm2 << 7; nn0 = tn2 << 7;
    }
    const u16* nap[4];
    const u16* nbp[4];
#pragma unroll
    for (int i = 0; i < 4; ++i) {
      nap[i] = A + (size_t)(nm0 + r + 32 * i) * lda + c;
      nbp[i] = Bt + (size_t)(nn0 + r + 32 * i) * ldb + c;
    }
    f32x4 acc[4][4];
#pragma unroll
    for (int m = 0; m < 4; ++m)
#pragma unroll
      for (int n = 0; n < 4; ++n) acc[m][n] = f32x4{0.f, 0.f, 0.f, 0.f};
    mainloop_chain(smem, ap, bp, nk, acc, first, has_next, nap, nbp);
    first = !chain;
#pragma unroll
    for (int m = 0; m < 4; ++m)
#pragma unroll
      for (int n = 0; n < 4; ++n) epi(m0 + wr * 64 + m * 16 + fr, n0 + wc * 64 + n * 16 + fq * 4, acc[m][n]);
    m0 = nm0; n0 = nn0;
#pragma unroll
    for (int i = 0; i < 4; ++i) { ap[i] = nap[i]; bp[i] = nbp[i]; }
  }
}

__device__ __forceinline__ void conv_flat(const float* src, u16* dst, size_t n, int bid, int nb) {
  const size_t stride = (size_t)nb * NT * 8;
  for (size_t i = ((size_t)bid * NT + opaque_tid()) * 8; i < n; i += stride) {
    const float4 a = *(const float4*)(src + i), b = *(const float4*)(src + i + 4);
    uint4 o = make_uint4(pack2(a.x, a.y), pack2(a.z, a.w), pack2(b.x, b.y), pack2(b.z, b.w));
    *(uint4*)(dst + i) = o;
  }
}

struct TJob {
  const float* src; u16* dst;
  int K, Kpad, N, ldsrc, lddst, nbatch;
  long sbs, dbs;
  int ntiles, pad_;
};
__device__ __forceinline__ void set_job(TJob& j, const float* src, u16* dst, int K, int Kpad, int N, int ldsrc,
                                        int lddst, int nbatch, long sbs, long dbs) {
  j.src = src; j.dst = dst; j.K = K; j.Kpad = Kpad; j.N = N; j.ldsrc = ldsrc; j.lddst = lddst; j.nbatch = nbatch;
  j.sbs = sbs; j.dbs = dbs; j.ntiles = nbatch * (Kpad >> 6) * ((N + 63) >> 6); j.pad_ = 0;
}
__device__ __forceinline__ void run_tjobs(const TJob* jobs, int nj, float* tile, int bid, int nb) {
  u16* tt = (u16*)tile;
  int total = 0;
  for (int j = 0; j < nj; ++j) total += jobs[j].ntiles;
  const int tid = opaque_tid();
  for (int t = bid; t < total; t += nb) {
    int j = 0, loc = t;
    while (loc >= jobs[j].ntiles) { loc -= jobs[j].ntiles; ++j; }
    const TJob& jb = jobs[j];
    const int tk = jb.Kpad >> 6, tn = (jb.N + 63) >> 6;
    const int b = loc / (tk * tn);
    const int rem = loc - b * (tk * tn);
    const int k0 = (rem / tn) << 6, n0 = (rem % tn) << 6;
    const float* src = jb.src + (size_t)b * jb.sbs;
    u16* dst = jb.dst + (size_t)b * jb.dbs;
    __syncthreads();
    {
      const int kr = tid >> 4, nq = (tid & 15) * 4;
      const bool nok = (n0 + nq) < jb.N;
#pragma unroll
      for (int i = 0; i < 4; ++i) {
        const int k = kr + 16 * i;
        float4 v = make_float4(0.f, 0.f, 0.f, 0.f);
        if (nok && (k0 + k) < jb.K) v = *(const float4*)(src + (size_t)(k0 + k) * jb.ldsrc + n0 + nq);
        tt[(nq + 0) * 66 + k] = f2bf(v.x);
        tt[(nq + 1) * 66 + k] = f2bf(v.y);
        tt[(nq + 2) * 66 + k] = f2bf(v.z);
        tt[(nq + 3) * 66 + k] = f2bf(v.w);
      }
    }
    __syncthreads();
    {
      const int n = tid >> 2, kc = (tid & 3) * 16;
      if (n0 + n < jb.N) {
        const unsigned* rp = (const unsigned*)(tt + n * 66 + kc);
        uint4 o0 = make_uint4(rp[0], rp[1], rp[2], rp[3]);
        uint4 o1 = make_uint4(rp[4], rp[5], rp[6], rp[7]);
        uint4* dp = (uint4*)(dst + (size_t)(n0 + n) * jb.lddst + k0 + kc);
        dp[0] = o0;
        dp[1] = o1;
      }
    }
  }
}

__device__ __forceinline__ void phase0(const Params& p, char* smem_c) {
  char* ws = p.ws;
  TJob* jobs = (TJob*)smem_c;
  float* tile = (float*)(smem_c + 2048);
  if (threadIdx.x == 0) {
    const float* w_in = p.in[2];
    u16* wint = (u16*)(ws + OFF_WINT);
    set_job(jobs[0], w_in, wint, 2048, 2048, 3360, 10544, 2048, 1, 0, 0);
    set_job(jobs[1], w_in + 3360, wint + (size_t)3456 * 2048, 2048, 2048, 3088, 10544, 2048, 1, 0, 0);
    set_job(jobs[2], w_in + 6448, wint + (size_t)6656 * 2048, 2048, 2048, 4096, 10544, 2048, 1, 0, 0);
    set_job(jobs[3], p.in[5], (u16*)(ws + OFF_WW2T), 64, 64, 1024, 1024, 64, 1, 0, 0);
    set_job(jobs[4], p.in[7], (u16*)(ws + OFF_WA2T), 64, 64, 1024, 1024, 64, 1, 0, 0);
    set_job(jobs[5], p.in[8], (u16*)(ws + OFF_WG2T), 160, 192, 1024, 1024, 192, 1, 0, 0);
  }
  __syncthreads();
  run_tjobs(jobs, 6, tile, blockIdx.x, gridDim.x);
  conv_flat(p.in[0], (u16*)(ws + OFF_XB), (size_t)NTOK * DM, blockIdx.x, gridDim.x);
  const int gtid = blockIdx.x * NT + opaque_tid(), gsz = gridDim.x * NT;
  {
    unsigned* w = (unsigned*)(ws + OFF_WINT);
    for (int i = gtid; i < 96 * 1024; i += gsz) w[(size_t)3360 * 1024 + i] = 0u;
    for (int i = gtid; i < 112 * 1024; i += gsz) w[(size_t)6544 * 1024 + i] = 0u;
  }
  {
    u16* wh = (u16*)(ws + OFF_WRH);
    u16* wl = (u16*)(ws + OFF_WRL);
    const float* w_rg = p.in[25];
    const float* w_re = p.in[27];
    for (int i = gtid; i < 48 * 2048; i += gsz) {
      const int n = i >> 11, k = i & 2047;
      float v = 0.f;
      if (n < 4) v = w_rg[k * 4 + n];
      else if (n < 36) v = w_re[k * 32 + (n - 4)];
      const u16 h = f2bf(v);
      wh[i] = h;
      wl[i] = f2bf(v - bf2f(h));
    }
  }
}

__device__ __forceinline__ void phase1(const Params& p, u16* smem) {
  char* ws = p.ws;
  u16* ur = (u16*)(ws + OFF_UR);
  u16* um = (u16*)(ws + OFF_UM);
  u16* ug = (u16*)(ws + OFF_UG);
  gemm_plain(smem, (const u16*)(ws + OFF_XB), 2048, (const u16*)(ws + OFF_WINT), 2048, NTOK, 10752, 2048,
             [=](int row, int col, f32x4 v) {
               u16* dst;
               if (col < 3456) dst = ur + (size_t)row * UR_W + col;
               else if (col < 6656) dst = um + (size_t)row * UM_W + (col - 3456);
               else dst = ug + (size_t)row * UG_W + (col - 6656);
               *(uint2*)dst = pack4(v);
             });
}

__device__ __forceinline__ void phase2(const Params& p, u16* smem) {
  char* ws = p.ws;
  const u16* um = (const u16*)(ws + OFF_UM);
  const u16* ur = (const u16*)(ws + OFF_UR);
  u16* qc = (u16*)(ws + OFF_QC);
  u16* kc = (u16*)(ws + OFF_KC);
  u16* kT = (u16*)(ws + OFF_KT);
  u16* vT = (u16*)(ws + OFF_VT);
  const float* conv_w = p.in[14];
  const float* conv_b = p.in[15];
  const int tid = opaque_tid();
  u16* tile = smem;
  for (int t = blockIdx.x; t < 8192; t += gridDim.x) {
    const int tb = t >> 5, cb = t & 31;
    const int tok0 = tb * 64, b = tok0 >> 12, ts0 = tok0 & 4095;
    const int tl = tid >> 2, cs = (tid & 3) * 16;
    const int tok = tok0 + tl;
    float val[16];
    if (cb < 16) {
      const int col0 = cb * 64 + cs;
#pragma unroll
      for (int e = 0; e < 16; ++e) val[e] = conv_b[col0 + e];
#pragma unroll
      for (int j = 0; j < 4; ++j) {
        const int ts = ts0 + tl - 3 + j;
        if (ts >= 0) {
          const uint4* src = (const uint4*)(um + (size_t)(b * 4096 + ts) * UM_W + col0);
          const uint4 a = src[0], c4 = src[1];
          const unsigned w[8] = {a.x, a.y, a.z, a.w, c4.x, c4.y, c4.z, c4.w};
#pragma unroll
          for (int e = 0; e < 8; ++e) {
            val[2 * e] += conv_w[j * 1024 + col0 + 2 * e] * lo2f(w[e]);
            val[2 * e + 1] += conv_w[j * 1024 + col0 + 2 * e + 1] * hi2f(w[e]);
          }
        }
      }
      const float sc = (cb >= 8) ? 0.125f : 1.0f;
#pragma unroll
      for (int e = 0; e < 16; ++e) val[e] = val[e] * sigmoidf_(val[e]) * sc;
      u16* dst = (cb < 8) ? (qc + (size_t)tok * 512 + col0) : (kc + (size_t)tok * 512 + (col0 - 512));
      uint4 o0 = make_uint4(pack2(val[0], val[1]), pack2(val[2], val[3]), pack2(val[4], val[5]), pack2(val[6], val[7]));
      uint4 o1 = make_uint4(pack2(val[8], val[9]), pack2(val[10], val[11]), pack2(val[12], val[13]), pack2(val[14], val[15]));
      ((uint4*)dst)[0] = o0;
      ((uint4*)dst)[1] = o1;
    } else {
      const int col0 = 1024 + (cb - 16) * 64 + cs;
      const uint4* src = (const uint4*)(um + (size_t)tok * UM_W + col0);
      const uint4 a = src[0], c4 = src[1];
      const unsigned w[8] = {a.x, a.y, a.z, a.w, c4.x, c4.y, c4.z, c4.w};
#pragma unroll
      for (int e = 0; e < 8; ++e) { val[2 * e] = lo2f(w[e]); val[2 * e + 1] = hi2f(w[e]); }
    }
    __syncthreads();
    if (cb >= 8) {
#pragma unroll
      for (int e = 0; e < 16; ++e) tile[tl * 66 + cs + e] = f2bf(val[e]);
    }
    __syncthreads();
    if (cb >= 8) {
      const int ch = tid >> 2, t4 = (tid & 3) * 16;
      unsigned o[8];
#pragma unroll
      for (int e = 0; e < 8; ++e)
        o[e] = (unsigned)tile[(t4 + 2 * e) * 66 + ch] | ((unsigned)tile[(t4 + 2 * e + 1) * 66 + ch] << 16);
      u16* dst;
      if (cb < 16) dst = kT + ((size_t)((b * 8 + (cb - 8)) * 64 + ch)) * 4096 + ts0 + t4;
      else dst = vT + ((size_t)((b * 8 + ((cb - 16) >> 1)) * 128 + ((cb - 16) & 1) * 64 + ch)) * 4096 + ts0 + t4;
      ((uint4*)dst)[0] = make_uint4(o[0], o[1], o[2], o[3]);
      ((uint4*)dst)[1] = make_uint4(o[4], o[5], o[6], o[7]);
    }
  }
  const int gtid = blockIdx.x * NT + tid, gsz = gridDim.x * NT;
  {
    float* ipre = (float*)(ws + OFF_IPRE);
    float* logf = (float*)(ws + OFF_LOGF);
    const float* i_bias = p.in[16];
    const float* f_bias = p.in[17];
    for (int i = gtid; i < NTOK * 8; i += gsz) {
      const int tok = i >> 3, h = i & 7, b = tok >> 12, ts = tok & 4095;
      const float ig = bf2f(um[(size_t)tok * UM_W + 2048 + h]) + i_bias[h];
      const float fg = bf2f(um[(size_t)tok * UM_W + 2056 + h]) + f_bias[h];
      const float lf = fminf(fg, 0.f) - log1pf(__expf(-fabsf(fg)));
      ipre[(b * 8 + h) * 4096 + ts] = ig;
      logf[(b * 8 + h) * 4096 + ts] = lf;
    }
  }
  {
    u16* lw = (u16*)(ws + OFF_LW);
    u16* la = (u16*)(ws + OFF_LA);
    u16* lg = (u16*)(ws + OFF_LG);
    const float* mu = p.in[3];
    for (int i = gtid; i < NTOK * 320; i += gsz) {
      const int tok = i / 320, j = i - tok * 320;
      if (j >= 288) { lg[(size_t)tok * 192 + 160 + (j - 288)] = 0; continue; }
      const int col = 3072 + j;
      const float z = bf2f(ur[(size_t)tok * UR_W + col]);
      const float zpl = bf2f(ur[(size_t)(((tok & 4095) > 0) ? tok - 1 : tok) * UR_W + col]);
      const float zp = ((tok & 4095) > 0) ? zpl : 0.f;
      const float zs = z + mu[col] * (zp - z);
      if (j < 64) lw[(size_t)tok * 64 + j] = f2bf(tanhf(zs));
      else if (j < 128) la[(size_t)tok * 64 + (j - 64)] = f2bf(zs);
      else lg[(size_t)tok * 192 + (j - 128)] = f2bf(sigmoidf_(zs));
    }
  }
}

__device__ __forceinline__ void chunk_gates(const Params& p, int bh, int t0, float* fbuf, float* ibuf, float* abuf) {
  const float* ipre = (const float*)(p.ws + OFF_IPRE);
  const float* logf = (const float*)(p.ws + OFF_LOGF);
  const int tid = opaque_tid();
  __syncthreads();
  if (tid < 64) {
    const float2 f = *(const float2*)(logf + bh * 4096 + t0 + 2 * tid);
    const float2 iv = *(const float2*)(ipre + bh * 4096 + t0 + 2 * tid);
    const float pair = f.x + f.y;
    float inc = pair;
#pragma unroll
    for (int o = 1; o < 64; o <<= 1) {
      const float up = __shfl_up(inc, o);
      if (tid >= o) inc += up;
    }
    const float excl = inc - pair;
    *(float2*)(fbuf + 2 * tid) = f;
    *(float2*)(ibuf + 2 * tid) = iv;
    *(float2*)(abuf + 2 * tid) = make_float2(excl + f.x, inc);
  }
  __syncthreads();
}

__device__ __forceinline__ void phase3(const Params& p, u16* smem) {
  char* ws = p.ws;
  const int tid = opaque_tid(), lane = tid & 63, wid = tid >> 6, fr = lane & 15, fq = lane >> 4;
  float* sf = (float*)smem;
  float* fbuf = sf, *ibuf = sf + 128, *abuf = sf + 256, *gebuf = sf + 384;
  const u16* kT = (const u16*)(ws + OFF_KT);
  const u16* vT = (const u16*)(ws + OFF_VT);
  float* dC = (float*)(ws + OFF_DC);
  float* dn = (float*)(ws + OFF_DN);
  float* atot = (float*)(ws + OFF_ATOT);
  float* glmx = (float*)(ws + OFF_GLMX);
  for (int unit = blockIdx.x; unit < 1024; unit += gridDim.x) {
    const int bh = unit >> 5, c = unit & 31, t0 = c * 128;
    chunk_gates(p, bh, t0, fbuf, ibuf, abuf);
    const float a_tot = abuf[127];
    float glmax = fmaxf(a_tot - abuf[lane] + ibuf[lane], a_tot - abuf[lane + 64] + ibuf[lane + 64]);
#pragma unroll
    for (int o = 32; o > 0; o >>= 1) glmax = fmaxf(glmax, __shfl_xor(glmax, o));
    if (tid < 128) gebuf[tid] = __expf(a_tot - abuf[tid] + ibuf[tid] - glmax);
    if (tid == 0) { atot[unit] = a_tot; glmx[unit] = glmax; }
    __syncthreads();
    f32x4 acc[2][4];
#pragma unroll
    for (int m = 0; m < 2; ++m)
#pragma unroll
      for (int n = 0; n < 4; ++n) acc[m][n] = f32x4{0.f, 0.f, 0.f, 0.f};
#pragma unroll
    for (int ks = 0; ks < 4; ++ks) {
      const int s0 = ks * 32 + fq * 8;
      bf16x8 rf[2], cf[4];
#pragma unroll
      for (int m = 0; m < 2; ++m)
        rf[m] = *(const bf16x8*)(vT + (size_t)(bh * 128 + wid * 32 + m * 16 + fr) * 4096 + t0 + s0);
#pragma unroll
      for (int n = 0; n < 4; ++n) {
        const bf16x8 raw = *(const bf16x8*)(kT + (size_t)(bh * 64 + n * 16 + fr) * 4096 + t0 + s0);
        bf16x8 sc;
#pragma unroll
        for (int j = 0; j < 8; ++j) sc[j] = (short)f2bf(bf2f((u16)raw[j]) * gebuf[s0 + j]);
        cf[n] = sc;
      }
#pragma unroll
      for (int m = 0; m < 2; ++m)
#pragma unroll
        for (int n = 0; n < 4; ++n) acc[m][n] = __builtin_amdgcn_mfma_f32_16x16x32_bf16(cf[n], rf[m], acc[m][n], 0, 0, 0);
    }
#pragma unroll
    for (int m = 0; m < 2; ++m)
#pragma unroll
      for (int n = 0; n < 4; ++n) {
        const int e = wid * 32 + m * 16 + fr, d = n * 16 + fq * 4;
        *(f32x4*)(dC + ((size_t)unit * 128 + e) * 64 + d) = acc[m][n];
      }
    if (tid < 64) {
      float s = 0.f;
      const u16* kr = kT + (size_t)(bh * 64 + tid) * 4096 + t0;
      for (int q = 0; q < 128; ++q) s += gebuf[q] * bf2f(kr[q]);
      dn[unit * 64 + tid] = s;
    }
  }
  {
    const float* w0 = p.in[4];
    u16* omd = (u16*)(ws + OFF_OMD);
    gemm_plain(smem, (const u16*)(ws + OFF_LW), 64, (const u16*)(ws + OFF_WW2T), 64, NTOK, 1024, 64,
               [=](int row, int col, f32x4 v) {
                 f32x4 o;
#pragma unroll
                 for (int j = 0; j < 4; ++j) {
                   const float z = w0[col + j] + v[j];
                   const float sp = fmaxf(-z, 0.f) + log1pf(__expf(-fabsf(z)));
                   const float w = -sp - 0.5f;
                   o[j] = -expm1f(-__expf(w));
                 }
                 *(uint2*)(omd + (size_t)row * 1024 + col) = pack4(o);
               });
    const float* a0 = p.in[6];
    u16* apl = (u16*)(ws + OFF_APL);
    gemm_plain(smem, (const u16*)(ws + OFF_LA), 64, (const u16*)(ws + OFF_WA2T), 64, NTOK, 1024, 64,
               [=](int row, int col, f32x4 v) {
                 f32x4 o;
#pragma unroll
                 for (int j = 0; j < 4; ++j) o[j] = sigmoidf_(a0[col + j] + v[j]);
                 *(uint2*)(apl + (size_t)row * 1024 + col) = pack4(o);
               });
    u16* g = (u16*)(ws + OFF_G);
    gemm_plain(smem, (const u16*)(ws + OFF_LG), 192, (const u16*)(ws + OFF_WG2T), 192, NTOK, 1024, 192,
               [=](int row, int col, f32x4 v) { *(uint2*)(g + (size_t)row * 1024 + col) = pack4(v); });
  }
}

__device__ __forceinline__ void phase4(const Params& p) {
  char* ws = p.ws;
  float* dC = (float*)(ws + OFF_DC);
  float* dn = (float*)(ws + OFF_DN);
  const float* atot = (const float*)(ws + OFF_ATOT);
  const float* glmx = (const float*)(ws + OFF_GLMX);
  float* mst = (float*)(ws + OFF_MST);
  const int gtid = blockIdx.x * NT + opaque_tid(), gsz = gridDim.x * NT;
  for (int idx = gtid; idx < 32 * 8256; idx += gsz) {
    const int bh = idx / 8256, e = idx - bh * 8256;
    float C = 0.f, m = -1.0e30f;
    float* qb = (e < 8192) ? (dC + (size_t)bh * 32 * 8192 + e) : (dn + bh * 32 * 64 + (e - 8192));
    const size_t qs = (e < 8192) ? 8192 : 64;
#pragma unroll 1
    for (int cb = 0; cb < 32; cb += 8) {
      float v[8], at[8], gm[8];
#pragma unroll
      for (int j = 0; j < 8; ++j) { v[j] = qb[(size_t)(cb + j) * qs]; at[j] = atot[bh * 32 + cb + j]; gm[j] = glmx[bh * 32 + cb + j]; }
#pragma unroll
      for (int j = 0; j < 8; ++j) {
        qb[(size_t)(cb + j) * qs] = C;
        if (e == 0) mst[bh * 32 + cb + j] = m;
        const float mn = fmaxf(at[j] + m, gm[j]);
        C = __expf(at[j] + m - mn) * C + __expf(gm[j] - mn) * v[j];
        m = mn;
      }
    }
  }
}

__device__ __forceinline__ void phase5(const Params& p, u16* smem) {
  char* ws = p.ws;
  const int tid = opaque_tid(), lane = tid & 63, fr = lane & 15, fq = lane >> 4;
  const int wid = __builtin_amdgcn_readfirstlane(tid >> 6);
  float* sf = (float*)smem;
  float* fbuf = sf, *ibuf = sf + 128, *abuf = sf + 256, *iabuf = sf + 384, *pmbuf = sf + 512;
  u16* Pb = smem + 2048 + wid * (32 * 136);
  const u16* qc = (const u16*)(ws + OFF_QC);
  const u16* kc = (const u16*)(ws + OFF_KC);
  const u16* vT = (const u16*)(ws + OFF_VT);
  const u16* um = (const u16*)(ws + OFF_UM);
  const float* Cst = (const float*)(ws + OFF_DC);
  const float* nst = (const float*)(ws + OFF_DN);
  const float* mstv = (const float*)(ws + OFF_MST);
  const float* mh_w = p.in[18];
  u16* ym = (u16*)(ws + OFF_YM);
  const unsigned vq = (unsigned)(fr * 512 + fq * 8) * 2u;
  const unsigned vc = (unsigned)(fr * 64 + fq * 8) * 4u;
  const unsigned vv = (unsigned)(fr * 4096 + fq * 8) * 2u;
  const unsigned vo = (unsigned)(fr * UM_W + fq * 4) * 2u;
  const unsigned vy = (unsigned)(fr * 1024 + fq * 4) * 2u;
  const unsigned vq2 = (unsigned)(fr * 512 + fq * 16) * 2u;
  for (int unit = blockIdx.x; unit < 1024; unit += gridDim.x) {
    const int bh = unit >> 5, c = unit & 31, t0 = c * 128, b = bh >> 3, h = bh & 7;
    chunk_gates(p, bh, t0, fbuf, ibuf, abuf);
    if (tid < 64) {
      const float2 iv = *(const float2*)(ibuf + 2 * tid);
      const float2 av = *(const float2*)(abuf + 2 * tid);
      const float ia0 = iv.x - av.x, ia1 = iv.y - av.y;
      const float m1 = fmaxf(ia0, ia1);
      float inc = m1;
#pragma unroll
      for (int o = 1; o < 64; o <<= 1) {
        const float up = __shfl_up(inc, o);
        if (tid >= o) inc = fmaxf(inc, up);
      }
      float excl = __shfl_up(inc, 1);
      if (tid == 0) excl = -3.0e38f;
      *(float2*)(iabuf + 2 * tid) = make_float2(ia0, ia1);
      *(float2*)(pmbuf + 2 * tid) = make_float2(fmaxf(excl, ia0), inc);
    }
    __syncthreads();
    const float mst = mstv[unit];
    const size_t tokbase = (size_t)b * 4096 + t0;
    const u16* kbase = kc + tokbase * 512 + h * 64;
    const float* cbase = Cst + (size_t)unit * 8192;
    const u16* vbase = vT + (size_t)bh * 128 * 4096 + t0;
#pragma unroll 1
    for (int mt = 0; mt < 2; ++mt) {
      const int trow = wid * 32 + mt * 16;
      const int t = trow + fr;
      const u16* qbase = qc + (tokbase + trow) * 512 + h * 64;
      bf16x8 Qf[2];
#pragma unroll
      for (int kk = 0; kk < 2; ++kk) Qf[kk] = ldu<bf16x8>(qbase + kk * 32, vq);
      const float Mt = fmaxf(mst, pmbuf[t]);
      const int dt = t - fq * 4;
      const float ie = __expf(mst - Mt);
      float rowsum = 0.f;
      {
        f32x4 S[8];
#pragma unroll
        for (int n = 0; n < 8; ++n) S[n] = f32x4{0.f, 0.f, 0.f, 0.f};
#pragma unroll
        for (int kk = 0; kk < 2; ++kk) {
#pragma unroll
          for (int n = 0; n < 8; ++n) {
            const bf16x8 kf = ldu<bf16x8>(kbase + n * 16 * 512 + kk * 32, vq);
            S[n] = __builtin_amdgcn_mfma_f32_16x16x32_bf16(kf, Qf[kk], S[n], 0, 0, 0);
          }
        }
#pragma unroll
        for (int n = 0; n < 8; ++n) {
          const f32x4 ia4 = *(const f32x4*)(iabuf + n * 16 + fq * 4);
          f32x4 pv;
#pragma unroll
          for (int j = 0; j < 4; ++j) {
            const float w = __expf((n * 16 + j <= dt) ? (ia4[j] - Mt) : -1.0e30f);
            pv[j] = S[n][j] * w;
            rowsum += pv[j];
          }
          *(uint2*)(Pb + (mt * 16 + fr) * 136 + n * 16 + fq * 4) = pack4(pv);
        }
        rowsum += __shfl_xor(rowsum, 16);
        rowsum += __shfl_xor(rowsum, 32);
      }
      __syncthreads();
      f32x4 acc[8];
#pragma unroll
      for (int n = 0; n < 8; ++n) acc[n] = f32x4{0.f, 0.f, 0.f, 0.f};
#pragma unroll
      for (int kk = 0; kk < 2; ++kk) {
#pragma unroll
        for (int n = 0; n < 8; ++n) {
          const float4 c0 = ldu<float4>(cbase + n * 16 * 64 + kk * 32, vc);
          const float4 c1 = ldu<float4>(cbase + n * 16 * 64 + kk * 32 + 4, vc);
          bf16x8 cf;
          cf[0] = (short)f2bf(c0.x); cf[1] = (short)f2bf(c0.y); cf[2] = (short)f2bf(c0.z); cf[3] = (short)f2bf(c0.w);
          cf[4] = (short)f2bf(c1.x); cf[5] = (short)f2bf(c1.y); cf[6] = (short)f2bf(c1.z); cf[7] = (short)f2bf(c1.w);
          acc[n] = __builtin_amdgcn_mfma_f32_16x16x32_bf16(cf, Qf[kk], acc[n], 0, 0, 0);
        }
      }
#pragma unroll
      for (int n = 0; n < 8; ++n)
#pragma unroll
        for (int j = 0; j < 4; ++j) acc[n][j] *= ie;
#pragma unroll
      for (int ks = 0; ks < 4; ++ks) {
        const bf16x8 pf = *(const bf16x8*)(Pb + (mt * 16 + fr) * 136 + ks * 32 + fq * 8);
#pragma unroll
        for (int n = 0; n < 8; ++n) {
          const bf16x8 vf = ldu<bf16x8>(vbase + (size_t)n * 16 * 4096 + ks * 32, vv);
          acc[n] = __builtin_amdgcn_mfma_f32_16x16x32_bf16(vf, pf, acc[n], 0, 0, 0);
        }
      }
      float qn = 0.f;
      {
        const float* np = nst + unit * 64 + fq * 16;
#pragma unroll
        for (int j8 = 0; j8 < 2; ++j8) {
          const bf16x8 q8 = ldu<bf16x8>(qbase + j8 * 8, vq2);
#pragma unroll
          for (int j = 0; j < 8; ++j) qn += bf2f((u16)q8[j]) * np[j8 * 8 + j];
        }
        qn += __shfl_xor(qn, 16);
        qn += __shfl_xor(qn, 32);
      }
      const float den = ie * qn + rowsum;
      const float mfull = abuf[t] + Mt;
      const float dd = fmaxf(fabsf(den), __expf(-mfull));
      const float inv = __builtin_amdgcn_rcpf(dd);
      float s1 = 0.f;
#pragma unroll
      for (int n = 0; n < 8; ++n)
#pragma unroll
        for (int j = 0; j < 4; ++j) { acc[n][j] *= inv; s1 += acc[n][j]; }
      s1 += __shfl_xor(s1, 16);
      s1 += __shfl_xor(s1, 32);
      const float mean = s1 * (1.f / 128.f);
      float s2 = 0.f;
#pragma unroll
      for (int n = 0; n < 8; ++n)
#pragma unroll
        for (int j = 0; j < 4; ++j) { const float d = acc[n][j] - mean; s2 += d * d; }
      s2 += __shfl_xor(s2, 16);
      s2 += __shfl_xor(s2, 32);
      const float rstd = rsqrtf(s2 * (1.f / 128.f) + 1e-6f);
      const u16* obase = um + (tokbase + trow) * UM_W + 2064 + h * 128;
      u16* ybase = ym + (tokbase + trow) * 1024 + h * 128;
#pragma unroll
      for (int n = 0; n < 8; ++n) {
        const f32x4 o = unpack4(ldu<uint2>(obase + n * 16, vo));
        const f32x4 mw = *(const f32x4*)(mh_w + h * 128 + n * 16 + fq * 4);
        f32x4 y;
#pragma unroll
        for (int j = 0; j < 4; ++j) y[j] = (acc[n][j] - mean) * rstd * mw[j] * sigmoidf_(o[j]);
        stu<uint2>(ybase + n * 16, vy, pack4(y));
      }
      asm volatile("" ::: "memory");
    }
  }
}

__device__ __forceinline__ void phase6(const Params& p) {
  char* ws = p.ws;
  const u16* ur = (const u16*)(ws + OFF_UR);
  const u16* apl = (const u16*)(ws + OFF_APL);
  u16* __restrict__ PR = (u16*)(ws + OFF_PR);
  u16* __restrict__ PK = (u16*)(ws + OFF_PK);
  u16* __restrict__ PKK = (u16*)(ws + OFF_PKK);
  u16* __restrict__ PBp = (u16*)(ws + OFF_PB2);
  u16* __restrict__ PV = (u16*)(ws + OFF_PV);
  const float* mu = p.in[3];
  const float* k_k = p.in[9];
  const float* k_a = p.in[10];
  const int gtid = blockIdx.x * NT + opaque_tid(), gsz = gridDim.x * NT;
#pragma unroll 2
  for (int i = gtid; i < NTOK * 256; i += gsz) {
    const int tok = i >> 8, c0 = (i & 255) * 4;
    const bool has_prev = (tok & 4095) > 0;
    const u16* cur = ur + (size_t)tok * UR_W + c0;
    const u16* prv = has_prev ? (cur - UR_W) : cur;
    f32x4 z[3];
#pragma unroll
    for (int q = 0; q < 3; ++q) {
      const f32x4 zc = unpack4(*(const uint2*)(cur + q * 1024));
      f32x4 zp = unpack4(*(const uint2*)(prv + q * 1024));
      if (!has_prev) zp = f32x4{0.f, 0.f, 0.f, 0.f};
      const f32x4 m4 = *(const f32x4*)(mu + q * 1024 + c0);
#pragma unroll
      for (int j = 0; j < 4; ++j) z[q][j] = zc[j] + m4[j] * (zp[j] - zc[j]);
    }
    const f32x4 a = unpack4(*(const uint2*)(apl + (size_t)tok * 1024 + c0));
    const f32x4 kk4 = *(const f32x4*)(k_k + c0);
    const f32x4 ka4 = *(const f32x4*)(k_a + c0);
    f32x4 kk, km, bb;
    float ss = 0.f;
#pragma unroll
    for (int j = 0; j < 4; ++j) { kk[j] = z[1][j] * kk4[j]; ss += kk[j] * kk[j]; }
    ss = reduce16(ss);
    const float inv = 1.f / fmaxf(sqrtf(ss), 1e-12f);
#pragma unroll
    for (int j = 0; j < 4; ++j) {
      kk[j] *= inv;
      km[j] = z[1][j] * (1.f + (a[j] - 1.f) * ka4[j]);
      bb[j] = a[j] * kk[j];
    }
    const size_t o = (size_t)tok * 1024 + c0;
    *(uint2*)(PR + o) = pack4(z[0]);
    *(uint2*)(PK + o) = pack4(km);
    *(uint2*)(PKK + o) = pack4(kk);
    *(uint2*)(PBp + o) = pack4(bb);
    *(uint2*)(PV + o) = pack4(z[2]);
  }
}

__device__ __forceinline__ void phase7(const Params& p, u16* smem) {
  char* ws = p.ws;
  const bool split = gridDim.x >= 512;
  const bool do_conv = split ? (blockIdx.x >= 256) : true;
  const int cbid = split ? (int)blockIdx.x - 256 : (int)blockIdx.x;
  const int cnb = split ? (int)gridDim.x - 256 : (int)gridDim.x;
  if (!do_conv || !split)
  for (int su = blockIdx.x; su < 256; su += gridDim.x) {
    __syncthreads();
  const int tid = opaque_tid(), lane = tid & 63, wid = tid >> 6, l16 = lane & 15, grp = lane >> 4;
  const int bh = su >> 2, rb = (su & 3) * 16;
  const int b = bh >> 4, h = bh & 15;
  const int row = rb + wid * 4 + grp;
  const u16* planes[5] = {(const u16*)(ws + OFF_PR), (const u16*)(ws + OFF_OMD), (const u16*)(ws + OFF_PK),
                          (const u16*)(ws + OFF_PKK), (const u16*)(ws + OFF_PB2)};
  const u16* PV = (const u16*)(ws + OFF_PV);
  u16* yraw = (u16*)(ws + OFF_YRAW);
  float* L = (float*)smem;
  float* LV = L + 32 * 320;
  const int st = tid >> 3, c8 = (tid & 7) * 8;
  const size_t tokb = (size_t)b * 4096;
  uint4 pre[5];
  uint4 prev = make_uint4(0, 0, 0, 0);
  auto issue = [&](int ch) {
    const size_t tok = tokb + ch * 32 + st;
#pragma unroll
    for (int q = 0; q < 5; ++q) pre[q] = *(const uint4*)(planes[q] + tok * 1024 + h * 64 + c8);
    if (tid < 64) prev = *(const uint4*)(PV + (tokb + ch * 32 + (tid >> 1)) * 1024 + h * 64 + rb + (tid & 1) * 8);
  };
  issue(0);
  f32x4 s = f32x4{0.f, 0.f, 0.f, 0.f};
  for (int ch = 0; ch < 128; ++ch) {
    __syncthreads();
#pragma unroll
    for (int q = 0; q < 5; ++q) {
      float* d = L + st * 320 + q * 64 + c8;
      *(f32x4*)d = f32x4{lo2f(pre[q].x), hi2f(pre[q].x), lo2f(pre[q].y), hi2f(pre[q].y)};
      *(f32x4*)(d + 4) = f32x4{lo2f(pre[q].z), hi2f(pre[q].z), lo2f(pre[q].w), hi2f(pre[q].w)};
    }
    if (tid < 64) {
      float* d = LV + (tid >> 1) * 16 + (tid & 1) * 8;
      *(f32x4*)d = f32x4{lo2f(prev.x), hi2f(prev.x), lo2f(prev.y), hi2f(prev.y)};
      *(f32x4*)(d + 4) = f32x4{lo2f(prev.z), hi2f(prev.z), lo2f(prev.w), hi2f(prev.w)};
    }
    __syncthreads();
    if (ch + 1 < 128) issue(ch + 1);
    const float* Lr = L + l16 * 4;
    const float* Lvp = LV + wid * 4 + grp;
    f32x4 kkv = *(const f32x4*)(Lr + 3 * 64);
    float sk = reduce16(s[0] * kkv[0] + s[1] * kkv[1] + s[2] * kkv[2] + s[3] * kkv[3]);
    u16* yp = yraw + (tokb + ch * 32) * 1024 + h * 64 + row;
#pragma unroll
    for (int t = 0; t < 32; ++t) {
      const float* Lt = Lr + t * 320;
      const f32x4 rv = *(const f32x4*)(Lt);
      const f32x4 od = *(const f32x4*)(Lt + 64);
      const f32x4 kv = *(const f32x4*)(Lt + 128);
      const f32x4 bv = *(const f32x4*)(Lt + 256);
      const float vv = Lvp[t * 16];
      const int tn = (t < 31) ? t + 1 : t;
      const f32x4 kkn = *(const f32x4*)(Lr + tn * 320 + 192);
      float py = 0.f, pk = 0.f;
#pragma unroll
      for (int j = 0; j < 4; ++j) {
        float sj = s[j];
        sj = sj - sj * od[j] + vv * kv[j] - sk * bv[j];
        s[j] = sj;
        py += sj * rv[j];
        pk += sj * kkn[j];
      }
      py = reduce16(py);
      pk = reduce16(pk);
      sk = pk;
      yp[t * 1024] = f2bf(py);
    }
  }
  }
  if (do_conv) {
    __syncthreads();
    TJob* jobs = (TJob*)smem;
    float* tile = (float*)((char*)smem + 2048);
    if (threadIdx.x == 0) {
      set_job(jobs[0], p.in[29], (u16*)(ws + OFF_WGT), 2048, 2048, 512, 512, 2048, 32, (long)2048 * 512, (long)512 * 2048);
      set_job(jobs[1], p.in[30], (u16*)(ws + OFF_WUT0), 2048, 2048, 512, 512, 2048, 22, (long)2048 * 512, (long)512 * 2048);
      set_job(jobs[2], p.in[30] + (size_t)22 * 2048 * 512, (u16*)(ws + OFF_WUT1), 2048, 2048, 512, 512, 2048, 10, (long)2048 * 512, (long)512 * 2048);
      set_job(jobs[3], p.in[20], (u16*)(ws + OFF_WBRT), 1024, 1024, 2048, 2048, 1024, 1, 0, 0);
      set_job(jobs[4], p.in[21], (u16*)(ws + OFF_WBMT), 1024, 1024, 2048, 2048, 1024, 1, 0, 0);
      set_job(jobs[5], p.in[22], (u16*)(ws + OFF_WOUTT), 2048, 2048, 2048, 2048, 2048, 1, 0, 0);
      set_job(jobs[6], p.in[32], (u16*)(ws + OFF_WPGT), 2048, 2048, 2048, 2048, 2048, 1, 0, 0);
      set_job(jobs[7], p.in[33], (u16*)(ws + OFF_WPLET), 256, 256, 2048, 2048, 256, 1, 0, 0);
    }
    __syncthreads();
    run_tjobs(jobs, 8, tile, cbid, cnb);
    conv_flat(p.in[1], (u16*)(ws + OFF_PB), (size_t)NTOK * 256, cbid, cnb);
  }
}

__device__ __forceinline__ void phase8(const Params& p) {
  char* ws = p.ws;
  const u16* yraw = (const u16*)(ws + OFF_YRAW);
  const u16* PR = (const u16*)(ws + OFF_PR);
  const u16* PK = (const u16*)(ws + OFF_PK);
  const u16* PV = (const u16*)(ws + OFF_PV);
  const u16* G = (const u16*)(ws + OFF_G);
  u16* __restrict__ yr = (u16*)(ws + OFF_YR);
  const float* r_k = p.in[11];
  const float* lnx_w = p.in[12];
  const float* lnx_b = p.in[13];
  const int gtid = blockIdx.x * NT + opaque_tid(), gsz = gridDim.x * NT;
#pragma unroll 2
  for (int i = gtid; i < NTOK * 256; i += gsz) {
    const int tok = i >> 8, c0 = (i & 255) * 4;
    const size_t o = (size_t)tok * 1024 + c0;
    const f32x4 y = unpack4(*(const uint2*)(yraw + o));
    const float mean = reduce16(y[0] + y[1] + y[2] + y[3]) * (1.f / 64.f);
    float s2 = 0.f;
#pragma unroll
    for (int j = 0; j < 4; ++j) { const float d = y[j] - mean; s2 += d * d; }
    const float rstd = rsqrtf(reduce16(s2) * (1.f / 64.f) + 64e-5f);
    const f32x4 r = unpack4(*(const uint2*)(PR + o));
    const f32x4 k = unpack4(*(const uint2*)(PK + o));
    const f32x4 v = unpack4(*(const uint2*)(PV + o));
    const f32x4 g = unpack4(*(const uint2*)(G + o));
    const f32x4 rk = *(const f32x4*)(r_k + c0);
    const f32x4 lw = *(const f32x4*)(lnx_w + c0);
    const f32x4 lb = *(const f32x4*)(lnx_b + c0);
    float dot = 0.f;
#pragma unroll
    for (int j = 0; j < 4; ++j) dot += r[j] * k[j] * rk[j];
    dot = reduce16(dot);
    f32x4 out;
#pragma unroll
    for (int j = 0; j < 4; ++j) out[j] = ((y[j] - mean) * rstd * lw[j] + lb[j] + dot * v[j]) * g[j];
    *(uint2*)(yr + o) = pack4(out);
  }
}

__device__ __forceinline__ void phase9(const Params& p, u16* smem) {
  char* ws = p.ws;
  const u16* yr = (const u16*)(ws + OFF_YR);
  const u16* ym = (const u16*)(ws + OFF_YM);
  const u16* wbr = (const u16*)(ws + OFF_WBRT);
  const u16* wbm = (const u16*)(ws + OFF_WBMT);
  const u16* ug = (const u16*)(ws + OFF_UG);
  const float* b_gate = p.in[19];
  u16* mixpre = (u16*)(ws + OFF_MIXPRE);
  const int tid = opaque_tid(), lane = tid & 63, wid = tid >> 6;
  const int wr = wid >> 1, wc = wid & 1, fr = lane & 15, fq = lane >> 4;
  const int r = tid >> 3, c = ((tid & 7) ^ ((tid >> 4) & 7)) * 8;
  bool first = true;
  for (int t = blockIdx.x; t < 128 * 16; t += gridDim.x) {
    int tm, tn;
    tile_map(t, 128, 16, tm, tn);
    const int m0 = tm << 7, n0 = tn << 7;
    const int t2 = t + gridDim.x;
    const bool has_next = t2 < 128 * 16;
    int nm0 = m0, nn0 = n0;
    if (has_next) { int tm2, tn2; tile_map(t2, 128, 16, tm2, tn2); nm0 = tm2 << 7; nn0 = tn2 << 7; }
    const u16* ap[4];
    const u16* bp[4];
    const u16* ap2[4];
    const u16* bp2[4];
    const u16* nap[4];
    const u16* nbp[4];
    f32x4 acc[4][4];
#pragma unroll
    for (int m = 0; m < 4; ++m)
#pragma unroll
      for (int n = 0; n < 4; ++n) acc[m][n] = f32x4{0.f, 0.f, 0.f, 0.f};
#pragma unroll
    for (int i = 0; i < 4; ++i) {
      ap[i] = ym + (size_t)(m0 + r + 32 * i) * 1024 + c;
      bp[i] = wbm + (size_t)(n0 + r + 32 * i) * 1024 + c;
      ap2[i] = yr + (size_t)(m0 + r + 32 * i) * 1024 + c;
      bp2[i] = wbr + (size_t)(n0 + r + 32 * i) * 1024 + c;
      nap[i] = ym + (size_t)(nm0 + r + 32 * i) * 1024 + c;
      nbp[i] = wbm + (size_t)(nn0 + r + 32 * i) * 1024 + c;
    }
    mainloop_chain(smem, ap, bp, 16, acc, first, true, ap2, bp2);
    first = false;
    uint2 pm[4][4];
#pragma unroll
    for (int m = 0; m < 4; ++m)
#pragma unroll
      for (int n = 0; n < 4; ++n) { pm[m][n] = pack4(acc[m][n]); acc[m][n] = f32x4{0.f, 0.f, 0.f, 0.f}; }
    mainloop_chain(smem, ap2, bp2, 16, acc, false, has_next, nap, nbp);
#pragma unroll
    for (int m = 0; m < 4; ++m)
#pragma unroll
      for (int n = 0; n < 4; ++n) {
        const int row = m0 + wr * 64 + m * 16 + fr, col = n0 + wc * 64 + n * 16 + fq * 4;
        const f32x4 gr = unpack4(*(const uint2*)(ug + (size_t)row * UG_W + col));
        const f32x4 gm = unpack4(*(const uint2*)(ug + (size_t)row * UG_W + 2048 + col));
        const f32x4 br = *(const f32x4*)(b_gate + col);
        const f32x4 bm = *(const f32x4*)(b_gate + 2048 + col);
        const f32x4 ymv = unpack4(pm[m][n]);
        f32x4 o;
#pragma unroll
        for (int j = 0; j < 4; ++j) o[j] = sigmoidf_(gr[j] + br[j]) * acc[m][n][j] + sigmoidf_(gm[j] + bm[j]) * ymv[j];
        *(uint2*)(mixpre + (size_t)row * 2048 + col) = pack4(o);
      }
  }
}

__device__ __forceinline__ void phase10(const Params& p, u16* smem) {
  char* ws = p.ws;
  const float* x = p.in[0];
  float* h1 = p.out;
  if (blockIdx.x == 0 && threadIdx.x < 32) ((int*)(ws + OFF_CNT))[threadIdx.x] = 0;
  const bool conv_first = blockIdx.x >= (gridDim.x >> 1);
#pragma unroll 1
  for (int pass = 0; pass < 2; ++pass) {
    if ((pass == 0) == conv_first) {
      __syncthreads();
      TJob* jobs = (TJob*)smem;
      float* tile = (float*)((char*)smem + 2048);
      if (threadIdx.x == 0) {
        set_job(jobs[0], p.in[31], (u16*)(ws + OFF_WDT), 512, 512, 2048, 2048, 512, 32, (long)512 * 2048, (long)2048 * 512);
      }
      __syncthreads();
      run_tjobs(jobs, 1, tile, blockIdx.x, gridDim.x);
    } else {
      gemm_plain(smem, (const u16*)(ws + OFF_MIXPRE), 2048, (const u16*)(ws + OFF_WOUTT), 2048, NTOK, 2048, 2048,
                 [=](int row, int col, f32x4 v) {
                   const f32x4 xv = *(const f32x4*)(x + (size_t)row * 2048 + col);
                   f32x4 o;
#pragma unroll
                   for (int j = 0; j < 4; ++j) o[j] = ALPHA_F * xv[j] + v[j];
                   *(f32x4*)(h1 + (size_t)row * 2048 + col) = o;
                 });
    }
  }
}

__device__ __forceinline__ void phase11(const Params& p, u16* smem) {
  char* ws = p.ws;
  const float* h1 = p.out;
  float* x1 = (float*)(ws + OFF_X1);
  u16* x1b = (u16*)(ws + OFF_X1B);
  u16* x1l = (u16*)(ws + OFF_X1L);
  const float* lnw = p.in[23];
  const float* lnb = p.in[24];
  const u16* wrh = (const u16*)(ws + OFF_WRH);
  const u16* wrl = (const u16*)(ws + OFF_WRL);
  const float* b_rg = p.in[26];
  const float* b_re = p.in[28];
  int* list = (int*)(ws + OFF_LIST);
  float* wts = (float*)(ws + OFF_WTS);
  int* cnt = (int*)(ws + OFF_CNT);
  const int tid = opaque_tid(), lane = tid & 63, wid = tid >> 6, fr = lane & 15, fq = lane >> 4;
  float* lgt = (float*)smem;
  for (int grp = blockIdx.x; grp < NTOK / 16; grp += gridDim.x) {
    const int row0 = grp * 16;
    for (int rr = 0; rr < 4; ++rr) {
      const int row = row0 + wid * 4 + rr;
      const float* src = h1 + (size_t)row * 2048;
      f32x4 v[8];
      float s = 0.f;
#pragma unroll
      for (int i = 0; i < 8; ++i) { v[i] = *(const f32x4*)(src + i * 256 + lane * 4); s += v[i][0] + v[i][1] + v[i][2] + v[i][3]; }
      const float mean = wave_sum(s) * (1.f / 2048.f);
      float s2 = 0.f;
#pragma unroll
      for (int i = 0; i < 8; ++i)
#pragma unroll
        for (int j = 0; j < 4; ++j) { const float d = v[i][j] - mean; s2 += d * d; }
      const float rstd = rsqrtf(wave_sum(s2) * (1.f / 2048.f) + 1e-5f);
#pragma unroll
      for (int i = 0; i < 8; ++i) {
        const int col = i * 256 + lane * 4;
        const f32x4 w = *(const f32x4*)(lnw + col);
        const f32x4 bb = *(const f32x4*)(lnb + col);
        f32x4 o, lo;
#pragma unroll
        for (int j = 0; j < 4; ++j) o[j] = (v[i][j] - mean) * rstd * w[j] + bb[j];
        *(f32x4*)(x1 + (size_t)row * 2048 + col) = o;
        const uint2 hb = pack4(o);
        const f32x4 hf = unpack4(hb);
#pragma unroll
        for (int j = 0; j < 4; ++j) lo[j] = o[j] - hf[j];
        *(uint2*)(x1b + (size_t)row * 2048 + col) = hb;
        *(uint2*)(x1l + (size_t)row * 2048 + col) = pack4(lo);
      }
    }
    __syncthreads();
    {
      f32x4 acc[3];
#pragma unroll
      for (int n = 0; n < 3; ++n) acc[n] = f32x4{0.f, 0.f, 0.f, 0.f};
#pragma unroll 2
      for (int ks = 0; ks < 16; ++ks) {
        const int k = wid * 512 + ks * 32 + fq * 8;
        const bf16x8 ah = *(const bf16x8*)(x1b + (size_t)(row0 + fr) * 2048 + k);
        const bf16x8 al = *(const bf16x8*)(x1l + (size_t)(row0 + fr) * 2048 + k);
#pragma unroll
        for (int n = 0; n < 3; ++n) {
          const bf16x8 wh = *(const bf16x8*)(wrh + (size_t)(n * 16 + fr) * 2048 + k);
          const bf16x8 wl = *(const bf16x8*)(wrl + (size_t)(n * 16 + fr) * 2048 + k);
          acc[n] = __builtin_amdgcn_mfma_f32_16x16x32_bf16(wh, ah, acc[n], 0, 0, 0);
          acc[n] = __builtin_amdgcn_mfma_f32_16x16x32_bf16(wl, ah, acc[n], 0, 0, 0);
          acc[n] = __builtin_amdgcn_mfma_f32_16x16x32_bf16(wh, al, acc[n], 0, 0, 0);
        }
      }
      float* part = lgt + 1024 + wid * 768;
#pragma unroll
      for (int n = 0; n < 3; ++n) *(f32x4*)(part + fr * 48 + n * 16 + fq * 4) = acc[n];
    }
    __syncthreads();
    for (int i = tid; i < 768; i += NT) lgt[i] = lgt[1024 + i] + lgt[1024 + 768 + i] + lgt[1024 + 1536 + i] + lgt[1024 + 2304 + i];
    __syncthreads();
    if (tid < 16) {
      const int row = row0 + tid;
      const float* L = lgt + tid * 48;
      float lg[4];
      int gs = 0;
#pragma unroll
      for (int j = 0; j < 4; ++j) lg[j] = L[j] + b_rg[j];
#pragma unroll
      for (int j = 1; j < 4; ++j) if (lg[j] > lg[gs]) gs = j;
      float den = 0.f;
#pragma unroll
      for (int j = 0; j < 4; ++j) den += __expf(lg[j] - lg[gs]);
      const float gw = 1.f / den;
      float le[8];
#pragma unroll
      for (int j = 0; j < 8; ++j) le[j] = L[4 + gs * 8 + j] + b_re[gs * 8 + j];
      int i0 = 0;
#pragma unroll
      for (int j = 1; j < 8; ++j) if (le[j] > le[i0]) i0 = j;
      int i1 = (i0 == 0) ? 1 : 0;
#pragma unroll
      for (int j = 0; j < 8; ++j) if (j != i0 && le[j] > le[i1]) i1 = j;
      const float e1 = __expf(le[i1] - le[i0]);
      const float w0 = gw / (1.f + e1), w1 = gw * e1 / (1.f + e1);
      const int ex0 = gs * 8 + i0, ex1 = gs * 8 + i1;
      const int p0 = atomicAdd(&cnt[ex0], 1);
      list[ex0 * 16384 + p0] = row * 2;
      wts[row * 2] = w0;
      const int p1 = atomicAdd(&cnt[ex1], 1);
      list[ex1 * 16384 + p1] = row * 2 + 1;
      wts[row * 2 + 1] = w1;
    }
    __syncthreads();
  }
}

__device__ __forceinline__ int expert_total(const int* cnt) {
  int acc = 0;
  for (int i = 0; i < 32; ++i) acc += (cnt[i] + 127) >> 7;
  return acc;
}
__device__ __forceinline__ void expert_lookup(const int* cnt, int rbg, int& e, int& rb, int& cnt_e) {
  int acc = 0;
  e = 0; rb = 0; cnt_e = 0;
  for (int i = 0; i < 32; ++i) {
    const int c = cnt[i];
    const int nb = (c + 127) >> 7;
    if (rbg >= acc && rbg < acc + nb) { e = i; rb = rbg - acc; cnt_e = c; }
    acc += nb;
  }
}

__device__ __forceinline__ void phase12(const Params& p, u16* smem) {
  char* ws = p.ws;
  const int* cntg = (const int*)(ws + OFF_CNT);
  const int nrb = expert_total(cntg);
  const int* list = (const int*)(ws + OFF_LIST);
  const u16* x1b = (const u16*)(ws + OFF_X1B);
  const u16* wgt = (const u16*)(ws + OFF_WGT);
  const u16* wut0 = (const u16*)(ws + OFF_WUT0);
  const u16* wut1 = (const u16*)(ws + OFF_WUT1);
  u16* H = (u16*)(ws + OFF_H);
  const int tid = opaque_tid(), lane = tid & 63, wid = tid >> 6;
  const int wr = wid >> 1, wc = wid & 1, fr = lane & 15, fq = lane >> 4;
  const int r = tid >> 3, c = ((tid & 7) ^ ((tid >> 4) & 7)) * 8;
  for (int t = blockIdx.x; t < nrb * 8; t += gridDim.x) {
    const int rbg = t >> 3, hc = t & 7;
    int e, rb, cnt_e;
    expert_lookup(cntg, rbg, e, rb, cnt_e);
    const u16* ap[4];
    const u16* bp[4];
#pragma unroll
    for (int i = 0; i < 4; ++i) {
      const int rr = r + 32 * i;
      const int slot = rb * 128 + rr;
      const int tok = (slot < cnt_e) ? (list[e * 16384 + slot] >> 1) : 0;
      ap[i] = x1b + (size_t)tok * 2048 + c;
      const int sub = rr >> 4, within = rr & 15;
      const int hcol = hc * 64 + (sub >> 1) * 16 + within;
      const u16* ub = (e < 22) ? (wut0 + (size_t)e * 512 * 2048) : (wut1 + (size_t)(e - 22) * 512 * 2048);
      bp[i] = ((sub & 1) ? ub : (wgt + (size_t)e * 512 * 2048)) + (size_t)hcol * 2048 + c;
    }
    f32x4 acc[4][4];
#pragma unroll
    for (int m = 0; m < 4; ++m)
#pragma unroll
      for (int n = 0; n < 4; ++n) acc[m][n] = f32x4{0.f, 0.f, 0.f, 0.f};
    mainloop(smem, ap, bp, 32, acc);
#pragma unroll
    for (int m = 0; m < 4; ++m)
#pragma unroll
      for (int pp = 0; pp < 2; ++pp) {
        const int rowl = wr * 64 + m * 16 + fr;
        const int hcol = hc * 64 + (wc * 2 + pp) * 16 + fq * 4;
        f32x4 o;
#pragma unroll
        for (int j = 0; j < 4; ++j) {
          const float g = acc[m][2 * pp][j], u = acc[m][2 * pp + 1][j];
          o[j] = g * sigmoidf_(g) * u;
        }
        *(uint2*)(H + ((size_t)rbg * 128 + rowl) * 512 + hcol) = pack4(o);
      }
  }
}

__device__ __forceinline__ void phase13(const Params& p, u16* smem) {
  char* ws = p.ws;
  const int* cntg = (const int*)(ws + OFF_CNT);
  const int nrb = expert_total(cntg);
  const int* list = (const int*)(ws + OFF_LIST);
  const float* wts = (const float*)(ws + OFF_WTS);
  const u16* H = (const u16*)(ws + OFF_H);
  const u16* wdt = (const u16*)(ws + OFF_WDT);
  u16* moey = (u16*)(ws + OFF_MOEY);
  const int tid = opaque_tid(), lane = tid & 63, wid = tid >> 6;
  const int wr = wid >> 1, wc = wid & 1, fr = lane & 15, fq = lane >> 4;
  const int r = tid >> 3, c = ((tid & 7) ^ ((tid >> 4) & 7)) * 8;
  for (int t = blockIdx.x; t < nrb * 16; t += gridDim.x) {
    const int rbg = t >> 4, nc = t & 15;
    int e, rb, cnt_e;
    expert_lookup(cntg, rbg, e, rb, cnt_e);
    const u16* ap[4];
    const u16* bp[4];
#pragma unroll
    for (int i = 0; i < 4; ++i) {
      ap[i] = H + ((size_t)rbg * 128 + r + 32 * i) * 512 + c;
      bp[i] = wdt + ((size_t)e * 2048 + nc * 128 + r + 32 * i) * 512 + c;
    }
    f32x4 acc[4][4];
#pragma unroll
    for (int m = 0; m < 4; ++m)
#pragma unroll
      for (int n = 0; n < 4; ++n) acc[m][n] = f32x4{0.f, 0.f, 0.f, 0.f};
    mainloop(smem, ap, bp, 8, acc);
#pragma unroll
    for (int m = 0; m < 4; ++m) {
      const int slot = rb * 128 + wr * 64 + m * 16 + fr;
      if (slot < cnt_e) {
        const int entry = list[e * 16384 + slot];
        const float w = wts[entry];
#pragma unroll
        for (int n = 0; n < 4; ++n) {
          f32x4 o;
#pragma unroll
          for (int j = 0; j < 4; ++j) o[j] = acc[m][n][j] * w;
          *(uint2*)(moey + (size_t)entry * 2048 + nc * 128 + wc * 64 + n * 16 + fq * 4) = pack4(o);
        }
      }
    }
  }
  const u16* x1b = (const u16*)(ws + OFF_X1B);
  const u16* pb = (const u16*)(ws + OFF_PB);
  const u16* wpg = (const u16*)(ws + OFF_WPGT);
  const u16* wple = (const u16*)(ws + OFF_WPLET);
  const float* x1 = (const float*)(ws + OFF_X1);
  float* h2 = p.out;
  bool first = true;
  for (int t = blockIdx.x; t < 128 * 16; t += gridDim.x) {
    int tm, tn;
    tile_map(t, 128, 16, tm, tn);
    const int m0 = tm << 7, n0 = tn << 7;
    const int t2 = t + gridDim.x;
    const bool has_next = t2 < 128 * 16;
    int nm0 = m0, nn0 = n0;
    if (has_next) { int tm2, tn2; tile_map(t2, 128, 16, tm2, tn2); nm0 = tm2 << 7; nn0 = tn2 << 7; }
    const u16* ap[4];
    const u16* bp[4];
    const u16* ap2[4];
    const u16* bp2[4];
    const u16* nap[4];
    const u16* nbp[4];
    f32x4 acc[4][4];
#pragma unroll
    for (int m = 0; m < 4; ++m)
#pragma unroll
      for (int n = 0; n < 4; ++n) acc[m][n] = f32x4{0.f, 0.f, 0.f, 0.f};
#pragma unroll
    for (int i = 0; i < 4; ++i) {
      ap[i] = pb + (size_t)(m0 + r + 32 * i) * 256 + c;
      bp[i] = wple + (size_t)(n0 + r + 32 * i) * 256 + c;
      ap2[i] = x1b + (size_t)(m0 + r + 32 * i) * 2048 + c;
      bp2[i] = wpg + (size_t)(n0 + r + 32 * i) * 2048 + c;
      nap[i] = pb + (size_t)(nm0 + r + 32 * i) * 256 + c;
      nbp[i] = wple + (size_t)(nn0 + r + 32 * i) * 256 + c;
    }
    mainloop_chain(smem, ap, bp, 4, acc, first, true, ap2, bp2);
    first = false;
    uint2 ple[4][4];
#pragma unroll
    for (int m = 0; m < 4; ++m)
#pragma unroll
      for (int n = 0; n < 4; ++n) { ple[m][n] = pack4(acc[m][n]); acc[m][n] = f32x4{0.f, 0.f, 0.f, 0.f}; }
    mainloop_chain(smem, ap2, bp2, 32, acc, false, has_next, nap, nbp);
#pragma unroll
    for (int m = 0; m < 4; ++m)
#pragma unroll
      for (int n = 0; n < 4; ++n) {
        const int row = m0 + wr * 64 + m * 16 + fr, col = n0 + wc * 64 + n * 16 + fq * 4;
        const f32x4 xv = *(const f32x4*)(x1 + (size_t)row * 2048 + col);
        const f32x4 pl = unpack4(ple[m][n]);
        f32x4 o;
#pragma unroll
        for (int j = 0; j < 4; ++j) o[j] = ALPHA_F * xv[j] + sigmoidf_(acc[m][n][j]) * pl[j];
        *(f32x4*)(h2 + (size_t)row * 2048 + col) = o;
      }
  }
}

__device__ __forceinline__ void phase14(const Params& p) {
  char* ws = p.ws;
  float* out = p.out;
  const u16* moey = (const u16*)(ws + OFF_MOEY);
  const float* lnw = p.in[34];
  const float* lnb = p.in[35];
  const int lane = opaque_tid() & 63;
  const int gw = (blockIdx.x * NT + opaque_tid()) >> 6, nw = (gridDim.x * NT) >> 6;
  for (int row0 = gw; row0 < NTOK; row0 += 2 * nw) {
    const int rows[2] = {row0, (row0 + nw < NTOK) ? row0 + nw : row0};
    f32x4 v[2][8];
    float s[2] = {0.f, 0.f};
#pragma unroll
    for (int q = 0; q < 2; ++q) {
      const float* src = out + (size_t)rows[q] * 2048;
#pragma unroll
      for (int i = 0; i < 8; ++i) {
        const int col = i * 256 + lane * 4;
        v[q][i] = *(const f32x4*)(src + col);
        const f32x4 m0 = unpack4(*(const uint2*)(moey + (size_t)(rows[q] * 2) * 2048 + col));
        const f32x4 m1 = unpack4(*(const uint2*)(moey + (size_t)(rows[q] * 2 + 1) * 2048 + col));
#pragma unroll
        for (int j = 0; j < 4; ++j) { v[q][i][j] += m0[j] + m1[j]; s[q] += v[q][i][j]; }
      }
    }
#pragma unroll
    for (int q = 0; q < 2; ++q) {
      const float mean = wave_sum(s[q]) * (1.f / 2048.f);
      float s2 = 0.f;
#pragma unroll
      for (int i = 0; i < 8; ++i)
#pragma unroll
        for (int j = 0; j < 4; ++j) { const float d = v[q][i][j] - mean; s2 += d * d; }
      const float rstd = rsqrtf(wave_sum(s2) * (1.f / 2048.f) + 1e-5f);
      if (q == 1 && rows[1] == rows[0]) continue;
      float* dst = out + (size_t)rows[q] * 2048;
#pragma unroll
      for (int i = 0; i < 8; ++i) {
        const int col = i * 256 + lane * 4;
        const f32x4 w = *(const f32x4*)(lnw + col);
        const f32x4 bb = *(const f32x4*)(lnb + col);
        f32x4 o;
#pragma unroll
        for (int j = 0; j < 4; ++j) o[j] = (v[q][i][j] - mean) * rstd * w[j] + bb[j];
        *(f32x4*)(dst + col) = o;
      }
    }
  }
}


#define XB_TMO      128
#define XB_XCNT(j)  (256  + 64 * (j))
#define XB_XSUB(j)  (1280 + 64 * (j))
#define XB_XGEN(j)  (2304 + 64 * (j))
#define XB_TOP      3328
#define XB_TOPGEN   3392
#define XCD_BAR_WORDS 3456
#define XB_SPIN_CAP (1u << 22)
__device__ __forceinline__ unsigned xb_ld(unsigned* p) { return __hip_atomic_load(p, __ATOMIC_RELAXED, __HIP_MEMORY_SCOPE_AGENT); }
__device__ __forceinline__ unsigned xb_add(unsigned* p, unsigned v) { return __hip_atomic_fetch_add(p, v, __ATOMIC_RELAXED, __HIP_MEMORY_SCOPE_AGENT); }
__device__ __forceinline__ unsigned xb_xcc_id() { return (unsigned)__builtin_amdgcn_s_getreg((3 << 11) | 20) & 0xFu; }
#define XB_SPIN(cond, bar) do { unsigned _sp = 0; while (cond) { __builtin_amdgcn_s_sleep(1); \
    if ((++_sp & 255u) == 0u) { if (xb_ld(&(bar)[XB_TMO])) break; if (_sp > XB_SPIN_CAP) { atomicAdd(&(bar)[XB_TMO], 1u); break; } } } } while (0)
struct XcdBarrier { unsigned* bar; unsigned x, nloc, nx; };
__device__ __forceinline__ void xcd_barrier(const XcdBarrier& b) {
  asm volatile("s_waitcnt vmcnt(0)" ::: "memory");
  __syncthreads();
  if (threadIdx.x == 0) {
    unsigned* bar = b.bar;
    __builtin_amdgcn_s_waitcnt(0);
    const unsigned nloc = b.nloc, nx = b.nx;
    const unsigned old = xb_add(&bar[XB_XSUB(b.x)], 1u);
    const unsigned gen = old / nloc;
    if (old + 1u == (gen + 1u) * nloc) {
      __builtin_amdgcn_fence(__ATOMIC_RELEASE, "agent");
      asm volatile("s_waitcnt vmcnt(0)" ::: "memory");
      const unsigned og = xb_add(&bar[XB_TOP], 1u);
      const unsigned tg = og / nx;
      if (og + 1u == (tg + 1u) * nx) xb_add(&bar[XB_TOPGEN], 1u);
      else XB_SPIN(xb_ld(&bar[XB_TOPGEN]) == tg, bar);
      __builtin_amdgcn_fence(__ATOMIC_ACQUIRE, "agent");
      xb_add(&bar[XB_XGEN(b.x)], 1u);
      asm volatile("s_waitcnt vmcnt(0)" ::: "memory");
    } else {
      XB_SPIN(xb_ld(&bar[XB_XGEN(b.x)]) == gen, bar);
      __builtin_amdgcn_fence(__ATOMIC_ACQUIRE, "agent");
      asm volatile("s_waitcnt vmcnt(0)" ::: "memory");
    }
  }
  __syncthreads();
}

#ifndef LASTP
#define LASTP 14
#endif
__global__ void __launch_bounds__(NT, 2) fwd_megakernel(Params p) {
  __shared__ __attribute__((aligned(16))) u16 smem[32768];
  cg::grid_group grid = cg::this_grid();
  XcdBarrier xb;
  xb.bar = (unsigned*)(p.ws + OFF_BAR);
  xb.x = xb_xcc_id();
  xb.nloc = 1u; xb.nx = 1u;
  if (threadIdx.x == 0) (void)xb_add(&xb.bar[XB_XCNT(xb.x)], 1u);
  phase0(p, (char*)smem);
  if (LASTP < 1) return;
  if (p.out == nullptr) grid.sync();
  __syncthreads();
  if (threadIdx.x == 0) {
    const unsigned G = gridDim.x;
    unsigned sum, cntx, mine, sp = 0u;
    for (;;) {
      sum = 0u; cntx = 0u; mine = 0u;
#pragma unroll
      for (unsigned j = 0; j < 16; ++j) {
        const unsigned c = xb_ld(&xb.bar[XB_XCNT(j)]);
        sum += c; cntx += (c > 0u) ? 1u : 0u; mine = (j == xb.x) ? c : mine;
      }
      if (sum == G) break;
      __builtin_amdgcn_s_sleep(1);
      if (++sp > XB_SPIN_CAP) break;
    }
    ((unsigned*)smem)[0] = mine > 0u ? mine : 1u;
    ((unsigned*)smem)[1] = cntx > 0u ? cntx : 1u;
  }
  __syncthreads();
  xb.nloc = (unsigned)__builtin_amdgcn_readfirstlane((int)((unsigned*)smem)[0]);
  xb.nx = (unsigned)__builtin_amdgcn_readfirstlane((int)((unsigned*)smem)[1]);
  xcd_barrier(xb);
  phase1(p, smem);
  if (LASTP < 2) return;
  xcd_barrier(xb);
  phase2(p, smem);
  if (LASTP < 3) return;
  xcd_barrier(xb);
  phase3(p, smem);
  if (LASTP < 4) return;
  xcd_barrier(xb);
  phase4(p);
  if (LASTP < 5) return;
  xcd_barrier(xb);
  phase5(p, smem);
  if (LASTP < 6) return;
  xcd_barrier(xb);
  phase6(p);
  if (LASTP < 7) return;
  xcd_barrier(xb);
  phase7(p, smem);
  if (LASTP < 8) return;
  xcd_barrier(xb);
  phase8(p);
  if (LASTP < 9) return;
  xcd_barrier(xb);
  phase9(p, smem);
  if (LASTP < 10) return;
  xcd_barrier(xb);
  phase10(p, smem);
  if (LASTP < 11) return;
  xcd_barrier(xb);
  phase11(p, smem);
  if (LASTP < 12) return;
  xcd_barrier(xb);
  phase12(p, smem);
  if (LASTP < 13) return;
  xcd_barrier(xb);
  phase13(p, smem);
  if (LASTP < 14) return;
  xcd_barrier(xb);
  phase14(p);
}

extern "C" void kernel_launch(void* const* d_in, const int* in_sizes, int n_in, void* d_out, int out_size, void* d_ws,
                              size_t ws_size, hipStream_t stream) {
  static int grid_blocks = 0;
  if (!grid_blocks) {
    int dev = 0, cus = 0, per_cu = 0;
    hipGetDevice(&dev);
    hipDeviceGetAttribute(&cus, hipDeviceAttributeMultiprocessorCount, dev);
    hipOccupancyMaxActiveBlocksPerMultiprocessor(&per_cu, fwd_megakernel, NT, 0);
    if (per_cu > 2) per_cu = 2;
    grid_blocks = cus * per_cu;
  }
  if (ws_size < WS_NEED || n_in < 36) {
    fprintf(stderr, "workspace too small: %zu < %zu\n", ws_size, (size_t)WS_NEED);
    return;
  }
  Params p{};
  for (int i = 0; i < 36; ++i) p.in[i] = (const float*)d_in[i];
  p.out = (float*)d_out;
  p.ws = (char*)d_ws;
  (void)hipMemsetAsync((char*)d_ws + OFF_BAR, 0, 16384, stream);
  void* args[] = {&p};
  hipError_t e = hipLaunchCooperativeKernel((void*)fwd_megakernel, dim3(grid_blocks), dim3(NT), args, 0, stream);
  if (e != hipSuccess) fprintf(stderr, "cooperative launch failed: %s (grid %d)\n", hipGetErrorString(e), grid_blocks);
}
```

```cpp
#include <hip/hip_runtime.h>
#include <hip/hip_cooperative_groups.h>
#include <cstdio>
namespace cg = cooperative_groups;

typedef unsigned short u16;
using bf16x8 = __attribute__((ext_vector_type(8))) short;
using f32x4 = __attribute__((ext_vector_type(4))) float;
using f32x2 = __attribute__((ext_vector_type(2))) float;

constexpr int NT = 256;
constexpr int NTOK = 16384, DM = 2048, SEQ = 4096;
constexpr int UR_W = 3456, UM_W = 3200, UG_W = 4096;
constexpr float ALPHA_F = 1.189207115002721f;

constexpr size_t SZ_UR = (size_t)NTOK * UR_W * 2;
constexpr size_t SZ_UM = (size_t)NTOK * UM_W * 2;
constexpr size_t SZ_UG = (size_t)NTOK * UG_W * 2;
constexpr size_t SZ_XB = (size_t)NTOK * DM * 2;
constexpr size_t SZ_WINT = (size_t)10752 * 2048 * 2;
constexpr size_t SZ_PL = (size_t)NTOK * 1024 * 2;
constexpr size_t OFF_R0 = 0;
constexpr size_t OFF_R1 = OFF_R0 + SZ_UR;
constexpr size_t OFF_R2 = OFF_R1 + SZ_UM;
constexpr size_t OFF_R3 = OFF_R2 + SZ_UG;
constexpr size_t OFF_R4 = OFF_R3 + SZ_XB;
constexpr size_t OFF_R5 = OFF_R4 + SZ_WINT;
constexpr size_t OFF_WBRT = OFF_R5;
constexpr size_t OFF_WBMT = OFF_WBRT + (size_t)2048 * 1024 * 2;
constexpr size_t OFF_WOUTT = OFF_WBMT + (size_t)2048 * 1024 * 2;
constexpr size_t OFF_WPGT = OFF_WOUTT + (size_t)2048 * 2048 * 2;
constexpr size_t OFF_WPLET = OFF_WPGT + (size_t)2048 * 2048 * 2;
constexpr size_t OFF_WW2T = OFF_WPLET + (size_t)2048 * 256 * 2;
constexpr size_t OFF_WA2T = OFF_WW2T + (size_t)1024 * 64 * 2;
constexpr size_t OFF_WG2T = OFF_WA2T + (size_t)1024 * 64 * 2;
constexpr size_t OFF_PB = OFF_WG2T + (size_t)1024 * 192 * 2;
constexpr size_t OFF_WRH = OFF_PB + (size_t)NTOK * 256 * 2;
constexpr size_t OFF_WRL = OFF_WRH + (size_t)48 * 2048 * 2;
constexpr size_t OFF_FREE = OFF_WRL + (size_t)48 * 2048 * 2;
constexpr size_t OFF_UR = OFF_R0, OFF_UM = OFF_R1, OFF_UG = OFF_R2, OFF_XB = OFF_R3, OFF_WINT = OFF_R4;
constexpr size_t OFF_QC = OFF_R3;
constexpr size_t OFF_KC = OFF_QC + (size_t)NTOK * 512 * 2;
constexpr size_t OFF_KT = OFF_KC + (size_t)NTOK * 512 * 2;
constexpr size_t OFF_MISC = OFF_KT + (size_t)NTOK * 512 * 2;
constexpr size_t OFF_IPRE = OFF_MISC;
constexpr size_t OFF_LOGF = OFF_IPRE + (size_t)32 * 4096 * 4;
constexpr size_t OFF_ATOT = OFF_LOGF + (size_t)32 * 4096 * 4;
constexpr size_t OFF_GLMX = OFF_ATOT + 4096;
constexpr size_t OFF_MST = OFF_GLMX + 4096;
constexpr size_t OFF_DN = OFF_MST + 4096;
constexpr size_t OFF_VT = OFF_R4;
constexpr size_t OFF_LW = OFF_R4 + SZ_PL;
constexpr size_t OFF_LA = OFF_LW + (size_t)NTOK * 64 * 2;
constexpr size_t OFF_LG = OFF_LA + (size_t)NTOK * 64 * 2;
constexpr size_t OFF_YM = OFF_FREE;
constexpr size_t OFF_OMD = OFF_YM + SZ_PL;
constexpr size_t OFF_APL = OFF_OMD + SZ_PL;
constexpr size_t OFF_YR = OFF_APL;
constexpr size_t OFF_G = OFF_APL + SZ_PL;
constexpr size_t OFF_DC = OFF_G + SZ_PL;
constexpr size_t OFF_YRAW = OFF_DC;
constexpr size_t OFF_PR = OFF_R1;
constexpr size_t OFF_PK = OFF_PR + SZ_PL;
constexpr size_t OFF_PKK = OFF_PK + SZ_PL;
constexpr size_t OFF_PB2 = OFF_R3;
constexpr size_t OFF_PV = OFF_PB2 + SZ_PL;
constexpr size_t OFF_MIXPRE = OFF_R3;
constexpr size_t OFF_WGT = OFF_R0;
constexpr size_t OFF_WUT0 = OFF_WGT + (size_t)32 * 512 * 2048 * 2;
constexpr size_t OFF_WUT1 = OFF_R4 + ((size_t)4 << 20);
constexpr size_t OFF_WDT = OFF_R1;
constexpr size_t OFF_X1 = OFF_R2;
constexpr size_t OFF_X1B = OFF_R3;
constexpr size_t OFF_LIST = OFF_R4;
constexpr size_t OFF_WTS = OFF_LIST + (size_t)32 * 16384 * 4;
constexpr size_t OFF_CNT = OFF_WTS + (size_t)32768 * 4;
constexpr size_t OFF_H = OFF_FREE;
constexpr size_t OFF_MOEY = OFF_H + (size_t)36864 * 512 * 2;
constexpr size_t OFF_X1L = OFF_MOEY;
constexpr size_t OFF_BAR = OFF_MOEY + (size_t)32768 * 2048 * 2;
constexpr size_t WS_NEED = OFF_BAR + 16384;
static_assert(OFF_DC + (size_t)1024 * 128 * 64 * 4 <= WS_NEED, "ws");
static_assert(OFF_WUT0 + (size_t)22 * 512 * 2048 * 2 <= OFF_R1, "up0 fit");
static_assert(OFF_WUT1 + (size_t)10 * 512 * 2048 * 2 <= OFF_R5, "up1 fit");
static_assert(OFF_WDT + (size_t)32 * 512 * 2048 * 2 <= OFF_R2, "down fit");
static_assert(OFF_CNT + 128 <= OFF_WUT1, "lists fit");
static_assert(OFF_DN + 1024 * 64 * 4 <= OFF_R4, "misc fit");
static_assert(OFF_LG + (size_t)NTOK * 192 * 2 <= OFF_R5, "lora fit");
static_assert(OFF_PKK + SZ_PL <= OFF_R2, "planes fit");

struct Params {
  const float* in[36];
  float* out;
  char* ws;
};

__device__ __forceinline__ u16 f2bf(float f) { return __builtin_bit_cast(u16, (__bf16)f); }
__device__ __forceinline__ float bf2f(u16 h) { return __uint_as_float(((unsigned)h) << 16); }
typedef __bf16 bf16x2_t __attribute__((ext_vector_type(2)));
__device__ __forceinline__ unsigned pack2(float a, float b) {
  f32x2 v = {a, b};
  return __builtin_bit_cast(unsigned, __builtin_convertvector(v, bf16x2_t));
}
__device__ __forceinline__ float lo2f(unsigned u) { return __uint_as_float(u << 16); }
__device__ __forceinline__ float hi2f(unsigned u) { return __uint_as_float(u & 0xffff0000u); }
__device__ __forceinline__ float sigmoidf_(float x) { return __builtin_amdgcn_rcpf(1.f + __expf(-x)); }
__device__ __forceinline__ uint2 pack4(f32x4 v) { return make_uint2(pack2(v[0], v[1]), pack2(v[2], v[3])); }
__device__ __forceinline__ f32x4 unpack4(uint2 u) {
  f32x4 r; r[0] = lo2f(u.x); r[1] = hi2f(u.x); r[2] = lo2f(u.y); r[3] = hi2f(u.y); return r;
}
__device__ __forceinline__ int opaque_tid() {
  int t = threadIdx.x;
  asm volatile("" : "+v"(t));
  return t;
}
template <int CTRL>
__device__ __forceinline__ float dpp_add(float v) {
  int x = __builtin_amdgcn_update_dpp(0, __float_as_int(v), CTRL, 0xf, 0xf, true);
  return v + __int_as_float(x);
}
__device__ __forceinline__ float reduce16(float v) {
  v = dpp_add<0xB1>(v);
  v = dpp_add<0x4E>(v);
  v = dpp_add<0x141>(v);
  v = dpp_add<0x140>(v);
  return v;
}
__device__ __forceinline__ float wave_sum(float v) {
#pragma unroll
  for (int o = 32; o > 0; o >>= 1) v += __shfl_xor(v, o);
  return v;
}

template <typename T>
__device__ __forceinline__ T ldu(const void* ubase, unsigned voff) { return *(const T*)((const char*)ubase + voff); }
template <typename T>
__device__ __forceinline__ void stu(void* ubase, unsigned voff, T v) { *(T*)((char*)ubase + voff) = v; }

#define GLDS16(g, l) __builtin_amdgcn_global_load_lds((const unsigned*)(g), (unsigned*)(l), 16, 0, 0)

__device__ __forceinline__ void mainloop(u16* smem, const u16* (&ap)[4], const u16* (&bp)[4], int nk,
                                         f32x4 (&acc)[4][4]) {
  const int tid = opaque_tid(), lane = tid & 63, wid = tid >> 6;
  const int wr = wid >> 1, wc = wid & 1, fr = lane & 15, fq = lane >> 4;
  u16* sA = smem;
  u16* sB = smem + 16384;
  __syncthreads();
#pragma unroll
  for (int i = 0; i < 4; ++i) {
    GLDS16(ap[i], sA + (tid + i * 256) * 8);
    GLDS16(bp[i], sB + (tid + i * 256) * 8);
  }
  const int sw = fr >> 1;
  for (int kt = 0; kt < nk; ++kt) {
    asm volatile("s_waitcnt vmcnt(0)" ::: "memory");
    __syncthreads();
    const int buf = kt & 1;
    if (kt + 1 < nk) {
      const int ko = (kt + 1) * 64;
      u16* dA = sA + (buf ^ 1) * 8192;
      u16* dB = sB + (buf ^ 1) * 8192;
#pragma unroll
      for (int i = 0; i < 4; ++i) {
        GLDS16(ap[i] + ko, dA + (tid + i * 256) * 8);
        GLDS16(bp[i] + ko, dB + (tid + i * 256) * 8);
      }
    }
    const u16* cA = sA + buf * 8192 + (wr * 64 + fr) * 64;
    const u16* cB = sB + buf * 8192 + (wc * 64 + fr) * 64;
#pragma unroll
    for (int kk = 0; kk < 2; ++kk) {
      bf16x8 af[4], bfr[4];
      const int ch = ((kk * 4 + fq) ^ sw) * 8;
#pragma unroll
      for (int m = 0; m < 4; ++m) af[m] = *(const bf16x8*)(cA + m * 1024 + ch);
#pragma unroll
      for (int n = 0; n < 4; ++n) bfr[n] = *(const bf16x8*)(cB + n * 1024 + ch);
#pragma unroll
      for (int m = 0; m < 4; ++m)
#pragma unroll
        for (int n = 0; n < 4; ++n)
          acc[m][n] = __builtin_amdgcn_mfma_f32_16x16x32_bf16(bfr[n], af[m], acc[m][n], 0, 0, 0);
    }
  }
}


__device__ __forceinline__ void mainloop_chain(u16* smem, const u16* (&ap)[4], const u16* (&bp)[4], int nk,
                                               f32x4 (&acc)[4][4], bool first, bool has_next,
                                               const u16* (&nap)[4], const u16* (&nbp)[4]) {
  const int tid = opaque_tid(), lane = tid & 63, wid = tid >> 6;
  const int wr = wid >> 1, wc = wid & 1, fr = lane & 15, fq = lane >> 4;
  u16* sA = smem;
  u16* sB = smem + 16384;
  if (first) {
    __syncthreads();
#pragma unroll
    for (int i = 0; i < 4; ++i) {
      GLDS16(ap[i], sA + (tid + i * 256) * 8);
      GLDS16(bp[i], sB + (tid + i * 256) * 8);
    }
  }
  const int sw = fr >> 1;
  for (int kt = 0; kt < nk; ++kt) {
    asm volatile("s_waitcnt vmcnt(0)" ::: "memory");
    __syncthreads();
    const int buf = kt & 1;
    u16* dA = sA + (buf ^ 1) * 8192;
    u16* dB = sB + (buf ^ 1) * 8192;
    if (kt + 1 < nk) {
      const int ko = (kt + 1) * 64;
#pragma unroll
      for (int i = 0; i < 4; ++i) {
        GLDS16(ap[i] + ko, dA + (tid + i * 256) * 8);
        GLDS16(bp[i] + ko, dB + (tid + i * 256) * 8);
      }
    } else if (has_next) {
#pragma unroll
      for (int i = 0; i < 4; ++i) {
        GLDS16(nap[i], dA + (tid + i * 256) * 8);
        GLDS16(nbp[i], dB + (tid + i * 256) * 8);
      }
    }
    __builtin_amdgcn_sched_barrier(0);
    const u16* cA = sA + buf * 8192 + (wr * 64 + fr) * 64;
    const u16* cB = sB + buf * 8192 + (wc * 64 + fr) * 64;
#pragma unroll
    for (int kk = 0; kk < 2; ++kk) {
      bf16x8 af[4], bfr[4];
      const int ch = ((kk * 4 + fq) ^ sw) * 8;
#pragma unroll
      for (int m = 0; m < 4; ++m) af[m] = *(const bf16x8*)(cA + m * 1024 + ch);
#pragma unroll
      for (int n = 0; n < 4; ++n) bfr[n] = *(const bf16x8*)(cB + n * 1024 + ch);
      __builtin_amdgcn_s_setprio(1);
#pragma unroll
      for (int m = 0; m < 4; ++m)
#pragma unroll
        for (int n = 0; n < 4; ++n)
          acc[m][n] = __builtin_amdgcn_mfma_f32_16x16x32_bf16(bfr[n], af[m], acc[m][n], 0, 0, 0);
      __builtin_amdgcn_s_setprio(0);
    }
    __builtin_amdgcn_sched_barrier(0);
  }
}


__device__ __forceinline__ void mainloop_rs(u16* smem, const u16* (&ap)[4], const u16* (&bp)[4], int nk,
                                            f32x4 (&acc)[4][4]) {
  const int tid = opaque_tid(), lane = tid & 63, wid = tid >> 6;
  const int wr = wid >> 1, wc = wid & 1, fr = lane & 15, fq = lane >> 4;
  u16* sA = smem;
  u16* sB = smem + 16384;
  const int sw = fr >> 1;
  uint4 ra00, ra01, ra02, ra03, rb00, rb01, rb02, rb03, ra10, ra11, ra12, ra13, rb10, rb11, rb12, rb13;
#define RS_LD(S, KT)                                  \
  {                                                   \
    const int ko_ = (KT) * 64;                        \
    ra##S##0 = *(const uint4*)(ap[0] + ko_);          \
    rb##S##0 = *(const uint4*)(bp[0] + ko_);          \
    ra##S##1 = *(const uint4*)(ap[1] + ko_);          \
    rb##S##1 = *(const uint4*)(bp[1] + ko_);          \
    ra##S##2 = *(const uint4*)(ap[2] + ko_);          \
    rb##S##2 = *(const uint4*)(bp[2] + ko_);          \
    ra##S##3 = *(const uint4*)(ap[3] + ko_);          \
    rb##S##3 = *(const uint4*)(bp[3] + ko_);          \
  }
#define RS_ST(S, BUF)                                              \
  {                                                                \
    *(uint4*)(sA + (BUF) * 8192 + (tid + 0 * 256) * 8) = ra##S##0; \
    *(uint4*)(sB + (BUF) * 8192 + (tid + 0 * 256) * 8) = rb##S##0; \
    *(uint4*)(sA + (BUF) * 8192 + (tid + 1 * 256) * 8) = ra##S##1; \
    *(uint4*)(sB + (BUF) * 8192 + (tid + 1 * 256) * 8) = rb##S##1; \
    *(uint4*)(sA + (BUF) * 8192 + (tid + 2 * 256) * 8) = ra##S##2; \
    *(uint4*)(sB + (BUF) * 8192 + (tid + 2 * 256) * 8) = rb##S##2; \
    *(uint4*)(sA + (BUF) * 8192 + (tid + 3 * 256) * 8) = ra##S##3; \
    *(uint4*)(sB + (BUF) * 8192 + (tid + 3 * 256) * 8) = rb##S##3; \
  }
#define RS_COMPUTE(BUF)                                                                            \
  {                                                                                                \
    const u16* cA = sA + (BUF) * 8192 + (wr * 64 + fr) * 64;                                       \
    const u16* cB = sB + (BUF) * 8192 + (wc * 64 + fr) * 64;                                       \
    _Pragma("unroll") for (int kk = 0; kk < 2; ++kk) {                                             \
      bf16x8 af[4], bfr[4];                                                                        \
      const int ch = ((kk * 4 + fq) ^ sw) * 8;                                                     \
      _Pragma("unroll") for (int m = 0; m < 4; ++m) af[m] = *(const bf16x8*)(cA + m * 1024 + ch);  \
      _Pragma("unroll") for (int n = 0; n < 4; ++n) bfr[n] = *(const bf16x8*)(cB + n * 1024 + ch); \
      _Pragma("unroll") for (int m = 0; m < 4; ++m)                                                \
        _Pragma("unroll") for (int n = 0; n < 4; ++n)                                              \
          acc[m][n] = __builtin_amdgcn_mfma_f32_16x16x32_bf16(bfr[n], af[m], acc[m][n], 0, 0, 0);  \
    }                                                                                              \
  }
  __syncthreads();
  RS_LD(0, 0);
  RS_LD(1, min(1, nk - 1));
  RS_ST(0, 0);
  RS_LD(0, min(2, nk - 1));
  __syncthreads();
  for (int kt = 0; kt < nk; kt += 2) {
    RS_ST(1, 1);
    RS_LD(1, min(kt + 3, nk - 1));
    RS_COMPUTE(0);
    __syncthreads();
    if (kt + 1 < nk) {
      RS_ST(0, 0);
      RS_LD(0, min(kt + 4, nk - 1));
      RS_COMPUTE(1);
      __syncthreads();
    }
  }
#undef RS_LD
#undef RS_ST
#undef RS_COMPUTE
}

__device__ __forceinline__ void tile_map(int t, int ntm, int ntn, int& tm, int& tn) {
  const int nt = ntm * ntn;
  const int q = nt >> 3, r = nt & 7, xcd = t & 7, off = t >> 3;
  const int t2 = (xcd < r ? xcd * (q + 1) : r * (q + 1) + (xcd - r) * q) + off;
  const int nig = 8 * ntn;
  const int gid = t2 / nig, fm = gid * 8;
  const int gsz = min(ntm - fm, 8);
  tm = fm + (t2 % nig) % gsz;
  tn = (t2 % nig) / gsz;
}

template <class Epi>
__device__ __forceinline__ void gemm_plain(u16* smem, const u16* A, int lda, const u16* Bt, int ldb, int M, int N,
                                           int K, Epi epi) {
  const int ntm = M >> 7, ntn = N >> 7, ntiles = ntm * ntn, nk = K >> 6;
  const int tid = opaque_tid(), lane = tid & 63, wid = tid >> 6;
  const int wr = wid >> 1, wc = wid & 1, fr = lane & 15, fq = lane >> 4;
  const int r = tid >> 3, c = ((tid & 7) ^ ((tid >> 4) & 7)) * 8;
  const bool chain = (nk & 1) == 0;
  int t = blockIdx.x;
  if (t >= ntiles) return;
  int tm, tn;
  tile_map(t, ntm, ntn, tm, tn);
  int m0 = tm << 7, n0 = tn << 7;
  const u16* ap[4];
  const u16* bp[4];
#pragma unroll
  for (int i = 0; i < 4; ++i) {
    ap[i] = A + (size_t)(m0 + r + 32 * i) * lda + c;
    bp[i] = Bt + (size_t)(n0 + r + 32 * i) * ldb + c;
  }
  bool first = true;
  for (; t < ntiles; t += gridDim.x) {
    const int t2 = t + gridDim.x;
    const bool has_next = chain && (t2 < ntiles);
    int nm0 = m0, nn0 = n0;
    if (t2 < ntiles) {
      int tm2, tn2;
      tile_map(t2, ntm, ntn, tm2, tn2);
      nm0 = tm2 << 7; nn0 = tn2 << 7;
    }
    const u16* nap[4];
    const u16* nbp[4];
#pragma unroll
    for (int i = 0; i < 4; ++i) {
      nap[i] = A + (size_t)(nm0 + r + 32 * i) * lda + c;
      nbp[i] = Bt + (size_t)(nn0 + r + 32 * i) * ldb + c;
    }
    f32x4 acc[4][4];
#pragma unroll
    for (int m = 0; m < 4; ++m)
#pragma unroll
      for (int n = 0; n < 4; ++n) acc[m][n] = f32x4{0.f, 0.f, 0.f, 0.f};
    mainloop_chain(smem, ap, bp, nk, acc, first, has_next, nap, nbp);
    first = !chain;
#pragma unroll
    for (int m = 0; m < 4; ++m)
#pragma unroll
      for (int n = 0; n < 4; ++n) epi(m0 + wr * 64 + m * 16 + fr, n0 + wc * 64 + n * 16 + fq * 4, acc[m][n]);
    m0 = nm0; n0 = nn0;
#pragma unroll
    for (int i = 0; i < 4; ++i) { ap[i] = nap[i]; bp[i] = nbp[i]; }
  }
}

__device__ __forceinline__ void conv_flat(const float* src, u16* dst, size_t n, int bid, int nb) {
  const size_t stride = (size_t)nb * NT * 8;
  for (size_t i = ((size_t)bid * NT + opaque_tid()) * 8; i < n; i += stride) {
    const float4 a = *(const float4*)(src + i), b = *(const float4*)(src + i + 4);
    uint4 o = make_uint4(pack2(a.x, a.y), pack2(a.z, a.w), pack2(b.x, b.y), pack2(b.z, b.w));
    *(uint4*)(dst + i) = o;
  }
}

struct TJob {
  const float* src; u16* dst;
  int K, Kpad, N, ldsrc, lddst, nbatch;
  long sbs, dbs;
  int ntiles, pad_;
};
__device__ __forceinline__ void set_job(TJob& j, const float* src, u16* dst, int K, int Kpad, int N, int ldsrc,
                                        int lddst, int nbatch, long sbs, long dbs) {
  j.src = src; j.dst = dst; j.K = K; j.Kpad = Kpad; j.N = N; j.ldsrc = ldsrc; j.lddst = lddst; j.nbatch = nbatch;
  j.sbs = sbs; j.dbs = dbs; j.ntiles = nbatch * (Kpad >> 6) * ((N + 63) >> 6); j.pad_ = 0;
}
__device__ __forceinline__ void run_tjobs(const TJob* jobs, int nj, float* tile, int bid, int nb) {
  u16* tt = (u16*)tile;
  int total = 0;
  for (int j = 0; j < nj; ++j) total += jobs[j].ntiles;
  const int tid = opaque_tid();
  for (int t = bid; t < total; t += nb) {
    int j = 0, loc = t;
    while (loc >= jobs[j].ntiles) { loc -= jobs[j].ntiles; ++j; }
    const TJob& jb = jobs[j];
    const int tk = jb.Kpad >> 6, tn = (jb.N + 63) >> 6;
    const int b = loc / (tk * tn);
    const int rem = loc - b * (tk * tn);
    const int k0 = (rem / tn) << 6, n0 = (rem % tn) << 6;
    const float* src = jb.src + (size_t)b * jb.sbs;
    u16* dst = jb.dst + (size_t)b * jb.dbs;
    __syncthreads();
    {
      const int kr = tid >> 4, nq = (tid & 15) * 4;
      const bool nok = (n0 + nq) < jb.N;
#pragma unroll
      for (int i = 0; i < 4; ++i) {
        const int k = kr + 16 * i;
        float4 v = make_float4(0.f, 0.f, 0.f, 0.f);
        if (nok && (k0 + k) < jb.K) v = *(const float4*)(src + (size_t)(k0 + k) * jb.ldsrc + n0 + nq);
        tt[(nq + 0) * 66 + k] = f2bf(v.x);
        tt[(nq + 1) * 66 + k] = f2bf(v.y);
        tt[(nq + 2) * 66 + k] = f2bf(v.z);
        tt[(nq + 3) * 66 + k] = f2bf(v.w);
      }
    }
    __syncthreads();
    {
      const int n = tid >> 2, kc = (tid & 3) * 16;
      if (n0 + n < jb.N) {
        const unsigned* rp = (const unsigned*)(tt + n * 66 + kc);
        uint4 o0 = make_uint4(rp[0], rp[1], rp[2], rp[3]);
        uint4 o1 = make_uint4(rp[4], rp[5], rp[6], rp[7]);
        uint4* dp = (uint4*)(dst + (size_t)(n0 + n) * jb.lddst + k0 + kc);
        dp[0] = o0;
        dp[1] = o1;
      }
    }
  }
}

__device__ __forceinline__ void phase0(const Params& p, char* smem_c) {
  char* ws = p.ws;
  TJob* jobs = (TJob*)smem_c;
  float* tile = (float*)(smem_c + 2048);
  if (threadIdx.x == 0) {
    const float* w_in = p.in[2];
    u16* wint = (u16*)(ws + OFF_WINT);
    set_job(jobs[0], w_in, wint, 2048, 2048, 3360, 10544, 2048, 1, 0, 0);
    set_job(jobs[1], w_in + 3360, wint + (size_t)3456 * 2048, 2048, 2048, 3088, 10544, 2048, 1, 0, 0);
    set_job(jobs[2], w_in + 6448, wint + (size_t)6656 * 2048, 2048, 2048, 4096, 10544, 2048, 1, 0, 0);
    set_job(jobs[3], p.in[5], (u16*)(ws + OFF_WW2T), 64, 64, 1024, 1024, 64, 1, 0, 0);
    set_job(jobs[4], p.in[7], (u16*)(ws + OFF_WA2T), 64, 64, 1024, 1024, 64, 1, 0, 0);
    set_job(jobs[5], p.in[8], (u16*)(ws + OFF_WG2T), 160, 192, 1024, 1024, 192, 1, 0, 0);
  }
  __syncthreads();
  run_tjobs(jobs, 6, tile, blockIdx.x, gridDim.x);
  conv_flat(p.in[0], (u16*)(ws + OFF_XB), (size_t)NTOK * DM, blockIdx.x, gridDim.x);
  const int gtid = blockIdx.x * NT + opaque_tid(), gsz = gridDim.x * NT;
  {
    unsigned* w = (unsigned*)(ws + OFF_WINT);
    for (int i = gtid; i < 96 * 1024; i += gsz) w[(size_t)3360 * 1024 + i] = 0u;
    for (int i = gtid; i < 112 * 1024; i += gsz) w[(size_t)6544 * 1024 + i] = 0u;
  }
  {
    u16* wh = (u16*)(ws + OFF_WRH);
    u16* wl = (u16*)(ws + OFF_WRL);
    const float* w_rg = p.in[25];
    const float* w_re = p.in[27];
    for (int i = gtid; i < 48 * 2048; i += gsz) {
      const int n = i >> 11, k = i & 2047;
      float v = 0.f;
      if (n < 4) v = w_rg[k * 4 + n];
      else if (n < 36) v = w_re[k * 32 + (n - 4)];
      const u16 h = f2bf(v);
      wh[i] = h;
      wl[i] = f2bf(v - bf2f(h));
    }
  }
}

__device__ __forceinline__ void phase1(const Params& p, u16* smem) {
  char* ws = p.ws;
  u16* ur = (u16*)(ws + OFF_UR);
  u16* um = (u16*)(ws + OFF_UM);
  u16* ug = (u16*)(ws + OFF_UG);
  gemm_plain(smem, (const u16*)(ws + OFF_XB), 2048, (const u16*)(ws + OFF_WINT), 2048, NTOK, 10752, 2048,
             [=](int row, int col, f32x4 v) {
               u16* dst;
               if (col < 3456) dst = ur + (size_t)row * UR_W + col;
               else if (col < 6656) dst = um + (size_t)row * UM_W + (col - 3456);
               else dst = ug + (size_t)row * UG_W + (col - 6656);
               *(uint2*)dst = pack4(v);
             });
}

__device__ __forceinline__ void phase2(const Params& p, u16* smem) {
  char* ws = p.ws;
  const u16* um = (const u16*)(ws + OFF_UM);
  const u16* ur = (const u16*)(ws + OFF_UR);
  u16* qc = (u16*)(ws + OFF_QC);
  u16* kc = (u16*)(ws + OFF_KC);
  u16* kT = (u16*)(ws + OFF_KT);
  u16* vT = (u16*)(ws + OFF_VT);
  const float* conv_w = p.in[14];
  const float* conv_b = p.in[15];
  const int tid = opaque_tid();
  u16* tile = smem;
  for (int t = blockIdx.x; t < 8192; t += gridDim.x) {
    const int tb = t >> 5, cb = t & 31;
    const int tok0 = tb * 64, b = tok0 >> 12, ts0 = tok0 & 4095;
    const int tl = tid >> 2, cs = (tid & 3) * 16;
    const int tok = tok0 + tl;
    float val[16];
    if (cb < 16) {
      const int col0 = cb * 64 + cs;
#pragma unroll
      for (int e = 0; e < 16; ++e) val[e] = conv_b[col0 + e];
#pragma unroll
      for (int j = 0; j < 4; ++j) {
        const int ts = ts0 + tl - 3 + j;
        if (ts >= 0) {
          const uint4* src = (const uint4*)(um + (size_t)(b * 4096 + ts) * UM_W + col0);
          const uint4 a = src[0], c4 = src[1];
          const unsigned w[8] = {a.x, a.y, a.z, a.w, c4.x, c4.y, c4.z, c4.w};
#pragma unroll
          for (int e = 0; e < 8; ++e) {
            val[2 * e] += conv_w[j * 1024 + col0 + 2 * e] * lo2f(w[e]);
            val[2 * e + 1] += conv_w[j * 1024 + col0 + 2 * e + 1] * hi2f(w[e]);
          }
        }
      }
      const float sc = (cb >= 8) ? 0.125f : 1.0f;
#pragma unroll
      for (int e = 0; e < 16; ++e) val[e] = val[e] * sigmoidf_(val[e]) * sc;
      u16* dst = (cb < 8) ? (qc + (size_t)tok * 512 + col0) : (kc + (size_t)tok * 512 + (col0 - 512));
      uint4 o0 = make_uint4(pack2(val[0], val[1]), pack2(val[2], val[3]), pack2(val[4], val[5]), pack2(val[6], val[7]));
      uint4 o1 = make_uint4(pack2(val[8], val[9]), pack2(val[10], val[11]), pack2(val[12], val[13]), pack2(val[14], val[15]));
      ((uint4*)dst)[0] = o0;
      ((uint4*)dst)[1] = o1;
    } else {
      const int col0 = 1024 + (cb - 16) * 64 + cs;
      const uint4* src = (const uint4*)(um + (size_t)tok * UM_W + col0);
      const uint4 a = src[0], c4 = src[1];
      const unsigned w[8] = {a.x, a.y, a.z, a.w, c4.x, c4.y, c4.z, c4.w};
#pragma unroll
      for (int e = 0; e < 8; ++e) { val[2 * e] = lo2f(w[e]); val[2 * e + 1] = hi2f(w[e]); }
    }
    __syncthreads();
    if (cb >= 8) {
#pragma unroll
      for (int e = 0; e < 16; ++e) tile[tl * 66 + cs + e] = f2bf(val[e]);
    }
    __syncthreads();
    if (cb >= 8) {
      const int ch = tid >> 2, t4 = (tid & 3) * 16;
      unsigned o[8];
#pragma unroll
      for (int e = 0; e < 8; ++e)
        o[e] = (unsigned)tile[(t4 + 2 * e) * 66 + ch] | ((unsigned)tile[(t4 + 2 * e + 1) * 66 + ch] << 16);
      u16* dst;
      if (cb < 16) dst = kT + ((size_t)((b * 8 + (cb - 8)) * 64 + ch)) * 4096 + ts0 + t4;
      else dst = vT + ((size_t)((b * 8 + ((cb - 16) >> 1)) * 128 + ((cb - 16) & 1) * 64 + ch)) * 4096 + ts0 + t4;
      ((uint4*)dst)[0] = make_uint4(o[0], o[1], o[2], o[3]);
      ((uint4*)dst)[1] = make_uint4(o[4], o[5], o[6], o[7]);
    }
  }
  const int gtid = blockIdx.x * NT + tid, gsz = gridDim.x * NT;
  {
    float* ipre = (float*)(ws + OFF_IPRE);
    float* logf = (float*)(ws + OFF_LOGF);
    const float* i_bias = p.in[16];
    const float* f_bias = p.in[17];
    for (int i = gtid; i < NTOK * 8; i += gsz) {
      const int tok = i >> 3, h = i & 7, b = tok >> 12, ts = tok & 4095;
      const float ig = bf2f(um[(size_t)tok * UM_W + 2048 + h]) + i_bias[h];
      const float fg = bf2f(um[(size_t)tok * UM_W + 2056 + h]) + f_bias[h];
      const float lf = fminf(fg, 0.f) - log1pf(__expf(-fabsf(fg)));
      ipre[(b * 8 + h) * 4096 + ts] = ig;
      logf[(b * 8 + h) * 4096 + ts] = lf;
    }
  }
  {
    u16* lw = (u16*)(ws + OFF_LW);
    u16* la = (u16*)(ws + OFF_LA);
    u16* lg = (u16*)(ws + OFF_LG);
    const float* mu = p.in[3];
    for (int i = gtid; i < NTOK * 320; i += gsz) {
      const int tok = i / 320, j = i - tok * 320;
      if (j >= 288) { lg[(size_t)tok * 192 + 160 + (j - 288)] = 0; continue; }
      const int col = 3072 + j;
      const float z = bf2f(ur[(size_t)tok * UR_W + col]);
      const float zpl = bf2f(ur[(size_t)(((tok & 4095) > 0) ? tok - 1 : tok) * UR_W + col]);
      const float zp = ((tok & 4095) > 0) ? zpl : 0.f;
      const float zs = z + mu[col] * (zp - z);
      if (j < 64) lw[(size_t)tok * 64 + j] = f2bf(tanhf(zs));
      else if (j < 128) la[(size_t)tok * 64 + (j - 64)] = f2bf(zs);
      else lg[(size_t)tok * 192 + (j - 128)] = f2bf(sigmoidf_(zs));
    }
  }
}

__device__ __forceinline__ void chunk_gates(const Params& p, int bh, int t0, float* fbuf, float* ibuf, float* abuf) {
  const float* ipre = (const float*)(p.ws + OFF_IPRE);
  const float* logf = (const float*)(p.ws + OFF_LOGF);
  const int tid = opaque_tid();
  __syncthreads();
  if (tid < 64) {
    const float2 f = *(const float2*)(logf + bh * 4096 + t0 + 2 * tid);
    const float2 iv = *(const float2*)(ipre + bh * 4096 + t0 + 2 * tid);
    const float pair = f.x + f.y;
    float inc = pair;
#pragma unroll
    for (int o = 1; o < 64; o <<= 1) {
      const float up = __shfl_up(inc, o);
      if (tid >= o) inc += up;
    }
    const float excl = inc - pair;
    *(float2*)(fbuf + 2 * tid) = f;
    *(float2*)(ibuf + 2 * tid) = iv;
    *(float2*)(abuf + 2 * tid) = make_float2(excl + f.x, inc);
  }
  __syncthreads();
}

__device__ __forceinline__ void phase3(const Params& p, u16* smem) {
  char* ws = p.ws;
  const int tid = opaque_tid(), lane = tid & 63, wid = tid >> 6, fr = lane & 15, fq = lane >> 4;
  float* sf = (float*)smem;
  float* fbuf = sf, *ibuf = sf + 128, *abuf = sf + 256, *gebuf = sf + 384;
  const u16* kT = (const u16*)(ws + OFF_KT);
  const u16* vT = (const u16*)(ws + OFF_VT);
  float* dC = (float*)(ws + OFF_DC);
  float* dn = (float*)(ws + OFF_DN);
  float* atot = (float*)(ws + OFF_ATOT);
  float* glmx = (float*)(ws + OFF_GLMX);
  for (int unit = blockIdx.x; unit < 1024; unit += gridDim.x) {
    const int bh = unit >> 5, c = unit & 31, t0 = c * 128;
    chunk_gates(p, bh, t0, fbuf, ibuf, abuf);
    const float a_tot = abuf[127];
    float glmax = fmaxf(a_tot - abuf[lane] + ibuf[lane], a_tot - abuf[lane + 64] + ibuf[lane + 64]);
#pragma unroll
    for (int o = 32; o > 0; o >>= 1) glmax = fmaxf(glmax, __shfl_xor(glmax, o));
    if (tid < 128) gebuf[tid] = __expf(a_tot - abuf[tid] + ibuf[tid] - glmax);
    if (tid == 0) { atot[unit] = a_tot; glmx[unit] = glmax; }
    __syncthreads();
    f32x4 acc[2][4];
#pragma unroll
    for (int m = 0; m < 2; ++m)
#pragma unroll
      for (int n = 0; n < 4; ++n) acc[m][n] = f32x4{0.f, 0.f, 0.f, 0.f};
#pragma unroll
    for (int ks = 0; ks < 4; ++ks) {
      const int s0 = ks * 32 + fq * 8;
      bf16x8 rf[2], cf[4];
#pragma unroll
      for (int m = 0; m < 2; ++m)
        rf[m] = *(const bf16x8*)(vT + (size_t)(bh * 128 + wid * 32 + m * 16 + fr) * 4096 + t0 + s0);
#pragma unroll
      for (int n = 0; n < 4; ++n) {
        const bf16x8 raw = *(const bf16x8*)(kT + (size_t)(bh * 64 + n * 16 + fr) * 4096 + t0 + s0);
        bf16x8 sc;
#pragma unroll
        for (int j = 0; j < 8; ++j) sc[j] = (short)f2bf(bf2f((u16)raw[j]) * gebuf[s0 + j]);
        cf[n] = sc;
      }
#pragma unroll
      for (int m = 0; m < 2; ++m)
#pragma unroll
        for (int n = 0; n < 4; ++n) acc[m][n] = __builtin_amdgcn_mfma_f32_16x16x32_bf16(cf[n], rf[m], acc[m][n], 0, 0, 0);
    }
#pragma unroll
    for (int m = 0; m < 2; ++m)
#pragma unroll
      for (int n = 0; n < 4; ++n) {
        const int e = wid * 32 + m * 16 + fr, d = n * 16 + fq * 4;
        *(f32x4*)(dC + ((size_t)unit * 128 + e) * 64 + d) = acc[m][n];
      }
    if (tid < 64) {
      float s = 0.f;
      const u16* kr = kT + (size_t)(bh * 64 + tid) * 4096 + t0;
      for (int q = 0; q < 128; ++q) s += gebuf[q] * bf2f(kr[q]);
      dn[unit * 64 + tid] = s;
    }
  }
  {
    const float* w0 = p.in[4];
    u16* omd = (u16*)(ws + OFF_OMD);
    gemm_plain(smem, (const u16*)(ws + OFF_LW), 64, (const u16*)(ws + OFF_WW2T), 64, NTOK, 1024, 64,
               [=](int row, int col, f32x4 v) {
                 f32x4 o;
#pragma unroll
                 for (int j = 0; j < 4; ++j) {
                   const float z = w0[col + j] + v[j];
                   const float sp = fmaxf(-z, 0.f) + log1pf(__expf(-fabsf(z)));
                   const float w = -sp - 0.5f;
                   o[j] = -expm1f(-__expf(w));
                 }
                 *(uint2*)(omd + (size_t)row * 1024 + col) = pack4(o);
               });
    const float* a0 = p.in[6];
    u16* apl = (u16*)(ws + OFF_APL);
    gemm_plain(smem, (const u16*)(ws + OFF_LA), 64, (const u16*)(ws + OFF_WA2T), 64, NTOK, 1024, 64,
               [=](int row, int col, f32x4 v) {
                 f32x4 o;
#pragma unroll
                 for (int j = 0; j < 4; ++j) o[j] = sigmoidf_(a0[col + j] + v[j]);
                 *(uint2*)(apl + (size_t)row * 1024 + col) = pack4(o);
               });
    u16* g = (u16*)(ws + OFF_G);
    gemm_plain(smem, (const u16*)(ws + OFF_LG), 192, (const u16*)(ws + OFF_WG2T), 192, NTOK, 1024, 192,
               [=](int row, int col, f32x4 v) { *(uint2*)(g + (size_t)row * 1024 + col) = pack4(v); });
  }
}

__device__ __forceinline__ void phase4(const Params& p) {
  char* ws = p.ws;
  float* dC = (float*)(ws + OFF_DC);
  float* dn = (float*)(ws + OFF_DN);
  const float* atot = (const float*)(ws + OFF_ATOT);
  const float* glmx = (const float*)(ws + OFF_GLMX);
  float* mst = (float*)(ws + OFF_MST);
  const int gtid = blockIdx.x * NT + opaque_tid(), gsz = gridDim.x * NT;
  for (int idx = gtid; idx < 32 * 8256; idx += gsz) {
    const int bh = idx / 8256, e = idx - bh * 8256;
    float C = 0.f, m = -1.0e30f;
    float* qb = (e < 8192) ? (dC + (size_t)bh * 32 * 8192 + e) : (dn + bh * 32 * 64 + (e - 8192));
    const size_t qs = (e < 8192) ? 8192 : 64;
#pragma unroll 1
    for (int cb = 0; cb < 32; cb += 8) {
      float v[8], at[8], gm[8];
#pragma unroll
      for (int j = 0; j < 8; ++j) { v[j] = qb[(size_t)(cb + j) * qs]; at[j] = atot[bh * 32 + cb + j]; gm[j] = glmx[bh * 32 + cb + j]; }
#pragma unroll
      for (int j = 0; j < 8; ++j) {
        qb[(size_t)(cb + j) * qs] = C;
        if (e == 0) mst[bh * 32 + cb + j] = m;
        const float mn = fmaxf(at[j] + m, gm[j]);
        C = __expf(at[j] + m - mn) * C + __expf(gm[j] - mn) * v[j];
        m = mn;
      }
    }
  }
}

__device__ __forceinline__ void phase5(const Params& p, u16* smem) {
  char* ws = p.ws;
  const int tid = opaque_tid(), lane = tid & 63, fr = lane & 15, fq = lane >> 4;
  const int wid = __builtin_amdgcn_readfirstlane(tid >> 6);
  float* sf = (float*)smem;
  float* fbuf = sf, *ibuf = sf + 128, *abuf = sf + 256, *iabuf = sf + 384, *pmbuf = sf + 512;
  u16* Pb = smem + 2048 + wid * (32 * 136);
  const u16* qc = (const u16*)(ws + OFF_QC);
  const u16* kc = (const u16*)(ws + OFF_KC);
  const u16* vT = (const u16*)(ws + OFF_VT);
  const u16* um = (const u16*)(ws + OFF_UM);
  const float* Cst = (const float*)(ws + OFF_DC);
  const float* nst = (const float*)(ws + OFF_DN);
  const float* mstv = (const float*)(ws + OFF_MST);
  const float* mh_w = p.in[18];
  u16* ym = (u16*)(ws + OFF_YM);
  const unsigned vq = (unsigned)(fr * 512 + fq * 8) * 2u;
  const unsigned vc = (unsigned)(fr * 64 + fq * 8) * 4u;
  const unsigned vv = (unsigned)(fr * 4096 + fq * 8) * 2u;
  const unsigned vo = (unsigned)(fr * UM_W + fq * 4) * 2u;
  const unsigned vy = (unsigned)(fr * 1024 + fq * 4) * 2u;
  const unsigned vq2 = (unsigned)(fr * 512 + fq * 16) * 2u;
  for (int unit = blockIdx.x; unit < 1024; unit += gridDim.x) {
    const int bh = unit >> 5, c = unit & 31, t0 = c * 128, b = bh >> 3, h = bh & 7;
    chunk_gates(p, bh, t0, fbuf, ibuf, abuf);
    if (tid < 64) {
      const float2 iv = *(const float2*)(ibuf + 2 * tid);
      const float2 av = *(const float2*)(abuf + 2 * tid);
      const float ia0 = iv.x - av.x, ia1 = iv.y - av.y;
      const float m1 = fmaxf(ia0, ia1);
      float inc = m1;
#pragma unroll
      for (int o = 1; o < 64; o <<= 1) {
        const float up = __shfl_up(inc, o);
        if (tid >= o) inc = fmaxf(inc, up);
      }
      float excl = __shfl_up(inc, 1);
      if (tid == 0) excl = -3.0e38f;
      *(float2*)(iabuf + 2 * tid) = make_float2(ia0, ia1);
      *(float2*)(pmbuf + 2 * tid) = make_float2(fmaxf(excl, ia0), inc);
    }
    __syncthreads();
    const float mst = mstv[unit];
    const size_t tokbase = (size_t)b * 4096 + t0;
    const u16* kbase = kc + tokbase * 512 + h * 64;
    const float* cbase = Cst + (size_t)unit * 8192;
    const u16* vbase = vT + (size_t)bh * 128 * 4096 + t0;
#pragma unroll 1
    for (int mt = 0; mt < 2; ++mt) {
      const int trow = wid * 32 + mt * 16;
      const int t = trow + fr;
      const u16* qbase = qc + (tokbase + trow) * 512 + h * 64;
      bf16x8 Qf[2];
#pragma unroll
      for (int kk = 0; kk < 2; ++kk) Qf[kk] = ldu<bf16x8>(qbase + kk * 32, vq);
      const float Mt = fmaxf(mst, pmbuf[t]);
      const int dt = t - fq * 4;
      const float ie = __expf(mst - Mt);
      float rowsum = 0.f;
      {
        f32x4 S[8];
#pragma unroll
        for (int n = 0; n < 8; ++n) S[n] = f32x4{0.f, 0.f, 0.f, 0.f};
#pragma unroll
        for (int kk = 0; kk < 2; ++kk) {
#pragma unroll
          for (int n = 0; n < 8; ++n) {
            const bf16x8 kf = ldu<bf16x8>(kbase + n * 16 * 512 + kk * 32, vq);
            S[n] = __builtin_amdgcn_mfma_f32_16x16x32_bf16(kf, Qf[kk], S[n], 0, 0, 0);
          }
        }
#pragma unroll
        for (int n = 0; n < 8; ++n) {
          const f32x4 ia4 = *(const f32x4*)(iabuf + n * 16 + fq * 4);
          f32x4 pv;
#pragma unroll
          for (int j = 0; j < 4; ++j) {
            const float w = __expf((n * 16 + j <= dt) ? (ia4[j] - Mt) : -1.0e30f);
            pv[j] = S[n][j] * w;
            rowsum += pv[j];
          }
          *(uint2*)(Pb + (mt * 16 + fr) * 136 + n * 16 + fq * 4) = pack4(pv);
        }
        rowsum += __shfl_xor(rowsum, 16);
        rowsum += __shfl_xor(rowsum, 32);
      }
      __syncthreads();
      f32x4 acc[8];
#pragma unroll
      for (int n = 0; n < 8; ++n) acc[n] = f32x4{0.f, 0.f, 0.f, 0.f};
#pragma unroll
      for (int kk = 0; kk < 2; ++kk) {
#pragma unroll
        for (int n = 0; n < 8; ++n) {
          const float4 c0 = ldu<float4>(cbase + n * 16 * 64 + kk * 32, vc);
          const float4 c1 = ldu<float4>(cbase + n * 16 * 64 + kk * 32 + 4, vc);
          bf16x8 cf;
          cf[0] = (short)f2bf(c0.x); cf[1] = (short)f2bf(c0.y); cf[2] = (short)f2bf(c0.z); cf[3] = (short)f2bf(c0.w);
          cf[4] = (short)f2bf(c1.x); cf[5] = (short)f2bf(c1.y); cf[6] = (short)f2bf(c1.z); cf[7] = (short)f2bf(c1.w);
          acc[n] = __builtin_amdgcn_mfma_f32_16x16x32_bf16(cf, Qf[kk], acc[n], 0, 0, 0);
        }
      }
#pragma unroll
      for (int n = 0; n < 8; ++n)
#pragma unroll
        for (int j = 0; j < 4; ++j) acc[n][j] *= ie;
#pragma unroll
      for (int ks = 0; ks < 4; ++ks) {
        const bf16x8 pf = *(const bf16x8*)(Pb + (mt * 16 + fr) * 136 + ks * 32 + fq * 8);
#pragma unroll
        for (int n = 0; n < 8; ++n) {
          const bf16x8 vf = ldu<bf16x8>(vbase + (size_t)n * 16 * 4096 + ks * 32, vv);
          acc[n] = __builtin_amdgcn_mfma_f32_16x16x32_bf16(vf, pf, acc[n], 0, 0, 0);
        }
      }
      float qn = 0.f;
      {
        const float* np = nst + unit * 64 + fq * 16;
#pragma unroll
        for (int j8 = 0; j8 < 2; ++j8) {
          const bf16x8 q8 = ldu<bf16x8>(qbase + j8 * 8, vq2);
#pragma unroll
          for (int j = 0; j < 8; ++j) qn += bf2f((u16)q8[j]) * np[j8 * 8 + j];
        }
        qn += __shfl_xor(qn, 16);
        qn += __shfl_xor(qn, 32);
      }
      const float den = ie * qn + rowsum;
      const float mfull = abuf[t] + Mt;
      const float dd = fmaxf(fabsf(den), __expf(-mfull));
      const float inv = __builtin_amdgcn_rcpf(dd);
      float s1 = 0.f;
#pragma unroll
      for (int n = 0; n < 8; ++n)
#pragma unroll
        for (int j = 0; j < 4; ++j) { acc[n][j] *= inv; s1 += acc[n][j]; }
      s1 += __shfl_xor(s1, 16);
      s1 += __shfl_xor(s1, 32);
      const float mean = s1 * (1.f / 128.f);
      float s2 = 0.f;
#pragma unroll
      for (int n = 0; n < 8; ++n)
#pragma unroll
        for (int j = 0; j < 4; ++j) { const float d = acc[n][j] - mean; s2 += d * d; }
      s2 += __shfl_xor(s2, 16);
      s2 += __shfl_xor(s2, 32);
      const float rstd = rsqrtf(s2 * (1.f / 128.f) + 1e-6f);
      const u16* obase = um + (tokbase + trow) * UM_W + 2064 + h * 128;
      u16* ybase = ym + (tokbase + trow) * 1024 + h * 128;
#pragma unroll
      for (int n = 0; n < 8; ++n) {
        const f32x4 o = unpack4(ldu<uint2>(obase + n * 16, vo));
        const f32x4 mw = *(const f32x4*)(mh_w + h * 128 + n * 16 + fq * 4);
        f32x4 y;
#pragma unroll
        for (int j = 0; j < 4; ++j) y[j] = (acc[n][j] - mean) * rstd * mw[j] * sigmoidf_(o[j]);
        stu<uint2>(ybase + n * 16, vy, pack4(y));
      }
      asm volatile("" ::: "memory");
    }
  }
}

__device__ __forceinline__ void phase6(const Params& p) {
  char* ws = p.ws;
  const u16* ur = (const u16*)(ws + OFF_UR);
  const u16* apl = (const u16*)(ws + OFF_APL);
  u16* __restrict__ PR = (u16*)(ws + OFF_PR);
  u16* __restrict__ PK = (u16*)(ws + OFF_PK);
  u16* __restrict__ PKK = (u16*)(ws + OFF_PKK);
  u16* __restrict__ PBp = (u16*)(ws + OFF_PB2);
  u16* __restrict__ PV = (u16*)(ws + OFF_PV);
  const float* mu = p.in[3];
  const float* k_k = p.in[9];
  const float* k_a = p.in[10];
  const int gtid = blockIdx.x * NT + opaque_tid(), gsz = gridDim.x * NT;
#pragma unroll 2
  for (int i = gtid; i < NTOK * 256; i += gsz) {
    const int tok = i >> 8, c0 = (i & 255) * 4;
    const bool has_prev = (tok & 4095) > 0;
    const u16* cur = ur + (size_t)tok * UR_W + c0;
    const u16* prv = has_prev ? (cur - UR_W) : cur;
    f32x4 z[3];
#pragma unroll
    for (int q = 0; q < 3; ++q) {
      const f32x4 zc = unpack4(*(const uint2*)(cur + q * 1024));
      f32x4 zp = unpack4(*(const uint2*)(prv + q * 1024));
      if (!has_prev) zp = f32x4{0.f, 0.f, 0.f, 0.f};
      const f32x4 m4 = *(const f32x4*)(mu + q * 1024 + c0);
#pragma unroll
      for (int j = 0; j < 4; ++j) z[q][j] = zc[j] + m4[j] * (zp[j] - zc[j]);
    }
    const f32x4 a = unpack4(*(const uint2*)(apl + (size_t)tok * 1024 + c0));
    const f32x4 kk4 = *(const f32x4*)(k_k + c0);
    const f32x4 ka4 = *(const f32x4*)(k_a + c0);
    f32x4 kk, km, bb;
    float ss = 0.f;
#pragma unroll
    for (int j = 0; j < 4; ++j) { kk[j] = z[1][j] * kk4[j]; ss += kk[j] * kk[j]; }
    ss = reduce16(ss);
    const float inv = 1.f / fmaxf(sqrtf(ss), 1e-12f);
#pragma unroll
    for (int j = 0; j < 4; ++j) {
      kk[j] *= inv;
      km[j] = z[1][j] * (1.f + (a[j] - 1.f) * ka4[j]);
      bb[j] = a[j] * kk[j];
    }
    const size_t o = (size_t)tok * 1024 + c0;
    *(uint2*)(PR + o) = pack4(z[0]);
    *(uint2*)(PK + o) = pack4(km);
    *(uint2*)(PKK + o) = pack4(kk);
    *(uint2*)(PBp + o) = pack4(bb);
    *(uint2*)(PV + o) = pack4(z[2]);
  }
}

__device__ __forceinline__ void phase7(const Params& p, u16* smem) {
  char* ws = p.ws;
  const bool split = gridDim.x >= 512;
  const bool do_conv = split ? (blockIdx.x >= 256) : true;
  const int cbid = split ? (int)blockIdx.x - 256 : (int)blockIdx.x;
  const int cnb = split ? (int)gridDim.x - 256 : (int)gridDim.x;
  if (!do_conv || !split)
  for (int su = blockIdx.x; su < 256; su += gridDim.x) {
    __syncthreads();
  const int tid = opaque_tid(), lane = tid & 63, wid = tid >> 6, l16 = lane & 15, grp = lane >> 4;
  const int bh = su >> 2, rb = (su & 3) * 16;
  const int b = bh >> 4, h = bh & 15;
  const int row = rb + wid * 4 + grp;
  const u16* planes[5] = {(const u16*)(ws + OFF_PR), (const u16*)(ws + OFF_OMD), (const u16*)(ws + OFF_PK),
                          (const u16*)(ws + OFF_PKK), (const u16*)(ws + OFF_PB2)};
  const u16* PV = (const u16*)(ws + OFF_PV);
  u16* yraw = (u16*)(ws + OFF_YRAW);
  float* L = (float*)smem;
  float* LV = L + 32 * 320;
  const int st = tid >> 3, c8 = (tid & 7) * 8;
  const size_t tokb = (size_t)b * 4096;
  uint4 pre[5];
  uint4 prev = make_uint4(0, 0, 0, 0);
  auto issue = [&](int ch) {
    const size_t tok = tokb + ch * 32 + st;
#pragma unroll
    for (int q = 0; q < 5; ++q) pre[q] = *(const uint4*)(planes[q] + tok * 1024 + h * 64 + c8);
    if (tid < 64) prev = *(const uint4*)(PV + (tokb + ch * 32 + (tid >> 1)) * 1024 + h * 64 + rb + (tid & 1) * 8);
  };
  issue(0);
  f32x4 s = f32x4{0.f, 0.f, 0.f, 0.f};
  for (int ch = 0; ch < 128; ++ch) {
    __syncthreads();
#pragma unroll
    for (int q = 0; q < 5; ++q) {
      float* d = L + st * 320 + q * 64 + c8;
      *(f32x4*)d = f32x4{lo2f(pre[q].x), hi2f(pre[q].x), lo2f(pre[q].y), hi2f(pre[q].y)};
      *(f32x4*)(d + 4) = f32x4{lo2f(pre[q].z), hi2f(pre[q].z), lo2f(pre[q].w), hi2f(pre[q].w)};
    }
    if (tid < 64) {
      float* d = LV + (tid >> 1) * 16 + (tid & 1) * 8;
      *(f32x4*)d = f32x4{lo2f(prev.x), hi2f(prev.x), lo2f(prev.y), hi2f(prev.y)};
      *(f32x4*)(d + 4) = f32x4{lo2f(prev.z), hi2f(prev.z), lo2f(prev.w), hi2f(prev.w)};
    }
    __syncthreads();
    if (ch + 1 < 128) issue(ch + 1);
    const float* Lr = L + l16 * 4;
    const float* Lvp = LV + wid * 4 + grp;
    f32x4 kkv = *(const f32x4*)(Lr + 3 * 64);
    float sk = reduce16(s[0] * kkv[0] + s[1] * kkv[1] + s[2] * kkv[2] + s[3] * kkv[3]);
    u16* yp = yraw + (tokb + ch * 32) * 1024 + h * 64 + row;
#pragma unroll
    for (int t = 0; t < 32; ++t) {
      const float* Lt = Lr + t * 320;
      const f32x4 rv = *(const f32x4*)(Lt);
      const f32x4 od = *(const f32x4*)(Lt + 64);
      const f32x4 kv = *(const f32x4*)(Lt + 128);
      const f32x4 bv = *(const f32x4*)(Lt + 256);
      const float vv = Lvp[t * 16];
      const int tn = (t < 31) ? t + 1 : t;
      const f32x4 kkn = *(const f32x4*)(Lr + tn * 320 + 192);
      float py = 0.f, pk = 0.f;
#pragma unroll
      for (int j = 0; j < 4; ++j) {
        float sj = s[j];
        sj = sj - sj * od[j] + vv * kv[j] - sk * bv[j];
        s[j] = sj;
        py += sj * rv[j];
        pk += sj * kkn[j];
      }
      py = reduce16(py);
      pk = reduce16(pk);
      sk = pk;
      yp[t * 1024] = f2bf(py);
    }
  }
  }
  if (do_conv) {
    __syncthreads();
    TJob* jobs = (TJob*)smem;
    float* tile = (float*)((char*)smem + 2048);
    if (threadIdx.x == 0) {
      set_job(jobs[0], p.in[29], (u16*)(ws + OFF_WGT), 2048, 2048, 512, 512, 2048, 32, (long)2048 * 512, (long)512 * 2048);
      set_job(jobs[1], p.in[30], (u16*)(ws + OFF_WUT0), 2048, 2048, 512, 512, 2048, 22, (long)2048 * 512, (long)512 * 2048);
      set_job(jobs[2], p.in[30] + (size_t)22 * 2048 * 512, (u16*)(ws + OFF_WUT1), 2048, 2048, 512, 512, 2048, 10, (long)2048 * 512, (long)512 * 2048);
      set_job(jobs[3], p.in[20], (u16*)(ws + OFF_WBRT), 1024, 1024, 2048, 2048, 1024, 1, 0, 0);
      set_job(jobs[4], p.in[21], (u16*)(ws + OFF_WBMT), 1024, 1024, 2048, 2048, 1024, 1, 0, 0);
      set_job(jobs[5], p.in[22], (u16*)(ws + OFF_WOUTT), 2048, 2048, 2048, 2048, 2048, 1, 0, 0);
      set_job(jobs[6], p.in[32], (u16*)(ws + OFF_WPGT), 2048, 2048, 2048, 2048, 2048, 1, 0, 0);
      set_job(jobs[7], p.in[33], (u16*)(ws + OFF_WPLET), 256, 256, 2048, 2048, 256, 1, 0, 0);
    }
    __syncthreads();
    run_tjobs(jobs, 8, tile, cbid, cnb);
    conv_flat(p.in[1], (u16*)(ws + OFF_PB), (size_t)NTOK * 256, cbid, cnb);
  }
}

__device__ __forceinline__ void phase8(const Params& p) {
  char* ws = p.ws;
  const u16* yraw = (const u16*)(ws + OFF_YRAW);
  const u16* PR = (const u16*)(ws + OFF_PR);
  const u16* PK = (const u16*)(ws + OFF_PK);
  const u16* PV = (const u16*)(ws + OFF_PV);
  const u16* G = (const u16*)(ws + OFF_G);
  u16* __restrict__ yr = (u16*)(ws + OFF_YR);
  const float* r_k = p.in[11];
  const float* lnx_w = p.in[12];
  const float* lnx_b = p.in[13];
  const int gtid = blockIdx.x * NT + opaque_tid(), gsz = gridDim.x * NT;
#pragma unroll 2
  for (int i = gtid; i < NTOK * 256; i += gsz) {
    const int tok = i >> 8, c0 = (i & 255) * 4;
    const size_t o = (size_t)tok * 1024 + c0;
    const f32x4 y = unpack4(*(const uint2*)(yraw + o));
    const float mean = reduce16(y[0] + y[1] + y[2] + y[3]) * (1.f / 64.f);
    float s2 = 0.f;
#pragma unroll
    for (int j = 0; j < 4; ++j) { const float d = y[j] - mean; s2 += d * d; }
    const float rstd = rsqrtf(reduce16(s2) * (1.f / 64.f) + 64e-5f);
    const f32x4 r = unpack4(*(const uint2*)(PR + o));
    const f32x4 k = unpack4(*(const uint2*)(PK + o));
    const f32x4 v = unpack4(*(const uint2*)(PV + o));
    const f32x4 g = unpack4(*(const uint2*)(G + o));
    const f32x4 rk = *(const f32x4*)(r_k + c0);
    const f32x4 lw = *(const f32x4*)(lnx_w + c0);
    const f32x4 lb = *(const f32x4*)(lnx_b + c0);
    float dot = 0.f;
#pragma unroll
    for (int j = 0; j < 4; ++j) dot += r[j] * k[j] * rk[j];
    dot = reduce16(dot);
    f32x4 out;
#pragma unroll
    for (int j = 0; j < 4; ++j) out[j] = ((y[j] - mean) * rstd * lw[j] + lb[j] + dot * v[j]) * g[j];
    *(uint2*)(yr + o) = pack4(out);
  }
}

__device__ __forceinline__ void phase9(const Params& p, u16* smem) {
  char* ws = p.ws;
  const u16* yr = (const u16*)(ws + OFF_YR);
  const u16* ym = (const u16*)(ws + OFF_YM);
  const u16* wbr = (const u16*)(ws + OFF_WBRT);
  const u16* wbm = (const u16*)(ws + OFF_WBMT);
  const u16* ug = (const u16*)(ws + OFF_UG);
  const float* b_gate = p.in[19];
  u16* mixpre = (u16*)(ws + OFF_MIXPRE);
  const int tid = opaque_tid(), lane = tid & 63, wid = tid >> 6;
  const int wr = wid >> 1, wc = wid & 1, fr = lane & 15, fq = lane >> 4;
  const int r = tid >> 3, c = ((tid & 7) ^ ((tid >> 4) & 7)) * 8;
  bool first = true;
  for (int t = blockIdx.x; t < 128 * 16; t += gridDim.x) {
    int tm, tn;
    tile_map(t, 128, 16, tm, tn);
    const int m0 = tm << 7, n0 = tn << 7;
    const int t2 = t + gridDim.x;
    const bool has_next = t2 < 128 * 16;
    int nm0 = m0, nn0 = n0;
    if (has_next) { int tm2, tn2; tile_map(t2, 128, 16, tm2, tn2); nm0 = tm2 << 7; nn0 = tn2 << 7; }
    const u16* ap[4];
    const u16* bp[4];
    const u16* ap2[4];
    const u16* bp2[4];
    const u16* nap[4];
    const u16* nbp[4];
    f32x4 acc[4][4];
#pragma unroll
    for (int m = 0; m < 4; ++m)
#pragma unroll
      for (int n = 0; n < 4; ++n) acc[m][n] = f32x4{0.f, 0.f, 0.f, 0.f};
#pragma unroll
    for (int i = 0; i < 4; ++i) {
      ap[i] = ym + (size_t)(m0 + r + 32 * i) * 1024 + c;
      bp[i] = wbm + (size_t)(n0 + r + 32 * i) * 1024 + c;
      ap2[i] = yr + (size_t)(m0 + r + 32 * i) * 1024 + c;
      bp2[i] = wbr + (size_t)(n0 + r + 32 * i) * 1024 + c;
      nap[i] = ym + (size_t)(nm0 + r + 32 * i) * 1024 + c;
      nbp[i] = wbm + (size_t)(nn0 + r + 32 * i) * 1024 + c;
    }
    mainloop_chain(smem, ap, bp, 16, acc, first, true, ap2, bp2);
    first = false;
    uint2 pm[4][4];
#pragma unroll
    for (int m = 0; m < 4; ++m)
#pragma unroll
      for (int n = 0; n < 4; ++n) { pm[m][n] = pack4(acc[m][n]); acc[m][n] = f32x4{0.f, 0.f, 0.f, 0.f}; }
    mainloop_chain(smem, ap2, bp2, 16, acc, false, has_next, nap, nbp);
#pragma unroll
    for (int m = 0; m < 4; ++m)
#pragma unroll
      for (int n = 0; n < 4; ++n) {
        const int row = m0 + wr * 64 + m * 16 + fr, col = n0 + wc * 64 + n * 16 + fq * 4;
        const f32x4 gr = unpack4(*(const uint2*)(ug + (size_t)row * UG_W + col));
        const f32x4 gm = unpack4(*(const uint2*)(ug + (size_t)row * UG_W + 2048 + col));
        const f32x4 br = *(const f32x4*)(b_gate + col);
        const f32x4 bm = *(const f32x4*)(b_gate + 2048 + col);
        const f32x4 ymv = unpack4(pm[m][n]);
        f32x4 o;
#pragma unroll
        for (int j = 0; j < 4; ++j) o[j] = sigmoidf_(gr[j] + br[j]) * acc[m][n][j] + sigmoidf_(gm[j] + bm[j]) * ymv[j];
        *(uint2*)(mixpre + (size_t)row * 2048 + col) = pack4(o);
      }
  }
}

__device__ __forceinline__ void phase10(const Params& p, u16* smem) {
  char* ws = p.ws;
  const float* x = p.in[0];
  float* h1 = p.out;
  if (blockIdx.x == 0 && threadIdx.x < 32) ((int*)(ws + OFF_CNT))[threadIdx.x] = 0;
  const bool conv_first = blockIdx.x >= (gridDim.x >> 1);
#pragma unroll 1
  for (int pass = 0; pass < 2; ++pass) {
    if ((pass == 0) == conv_first) {
      __syncthreads();
      TJob* jobs = (TJob*)smem;
      float* tile = (float*)((char*)smem + 2048);
      if (threadIdx.x == 0) {
        set_job(jobs[0], p.in[31], (u16*)(ws + OFF_WDT), 512, 512, 2048, 2048, 512, 32, (long)512 * 2048, (long)2048 * 512);
      }
      __syncthreads();
      run_tjobs(jobs, 1, tile, blockIdx.x, gridDim.x);
    } else {
      gemm_plain(smem, (const u16*)(ws + OFF_MIXPRE), 2048, (const u16*)(ws + OFF_WOUTT), 2048, NTOK, 2048, 2048,
                 [=](int row, int col, f32x4 v) {
                   const f32x4 xv = *(const f32x4*)(x + (size_t)row * 2048 + col);
                   f32x4 o;
#pragma unroll
                   for (int j = 0; j < 4; ++j) o[j] = ALPHA_F * xv[j] + v[j];
                   *(f32x4*)(h1 + (size_t)row * 2048 + col) = o;
                 });
    }
  }
}

__device__ __forceinline__ void phase11(const Params& p, u16* smem) {
  char* ws = p.ws;
  const float* h1 = p.out;
  float* x1 = (float*)(ws + OFF_X1);
  u16* x1b = (u16*)(ws + OFF_X1B);
  u16* x1l = (u16*)(ws + OFF_X1L);
  const float* lnw = p.in[23];
  const float* lnb = p.in[24];
  const u16* wrh = (const u16*)(ws + OFF_WRH);
  const u16* wrl = (const u16*)(ws + OFF_WRL);
  const float* b_rg = p.in[26];
  const float* b_re = p.in[28];
  int* list = (int*)(ws + OFF_LIST);
  float* wts = (float*)(ws + OFF_WTS);
  int* cnt = (int*)(ws + OFF_CNT);
  const int tid = opaque_tid(), lane = tid & 63, wid = tid >> 6, fr = lane & 15, fq = lane >> 4;
  float* lgt = (float*)smem;
  for (int grp = blockIdx.x; grp < NTOK / 16; grp += gridDim.x) {
    const int row0 = grp * 16;
    for (int rr = 0; rr < 4; ++rr) {
      const int row = row0 + wid * 4 + rr;
      const float* src = h1 + (size_t)row * 2048;
      f32x4 v[8];
      float s = 0.f;
#pragma unroll
      for (int i = 0; i < 8; ++i) { v[i] = *(const f32x4*)(src + i * 256 + lane * 4); s += v[i][0] + v[i][1] + v[i][2] + v[i][3]; }
      const float mean = wave_sum(s) * (1.f / 2048.f);
      float s2 = 0.f;
#pragma unroll
      for (int i = 0; i < 8; ++i)
#pragma unroll
        for (int j = 0; j < 4; ++j) { const float d = v[i][j] - mean; s2 += d * d; }
      const float rstd = rsqrtf(wave_sum(s2) * (1.f / 2048.f) + 1e-5f);
#pragma unroll
      for (int i = 0; i < 8; ++i) {
        const int col = i * 256 + lane * 4;
        const f32x4 w = *(const f32x4*)(lnw + col);
        const f32x4 bb = *(const f32x4*)(lnb + col);
        f32x4 o, lo;
#pragma unroll
        for (int j = 0; j < 4; ++j) o[j] = (v[i][j] - mean) * rstd * w[j] + bb[j];
        *(f32x4*)(x1 + (size_t)row * 2048 + col) = o;
        const uint2 hb = pack4(o);
        const f32x4 hf = unpack4(hb);
#pragma unroll
        for (int j = 0; j < 4; ++j) lo[j] = o[j] - hf[j];
        *(uint2*)(x1b + (size_t)row * 2048 + col) = hb;
        *(uint2*)(x1l + (size_t)row * 2048 + col) = pack4(lo);
      }
    }
    __syncthreads();
    {
      f32x4 acc[3];
#pragma unroll
      for (int n = 0; n < 3; ++n) acc[n] = f32x4{0.f, 0.f, 0.f, 0.f};
#pragma unroll 2
      for (int ks = 0; ks < 16; ++ks) {
        const int k = wid * 512 + ks * 32 + fq * 8;
        const bf16x8 ah = *(const bf16x8*)(x1b + (size_t)(row0 + fr) * 2048 + k);
        const bf16x8 al = *(const bf16x8*)(x1l + (size_t)(row0 + fr) * 2048 + k);
#pragma unroll
        for (int n = 0; n < 3; ++n) {
          const bf16x8 wh = *(const bf16x8*)(wrh + (size_t)(n * 16 + fr) * 2048 + k);
          const bf16x8 wl = *(const bf16x8*)(wrl + (size_t)(n * 16 + fr) * 2048 + k);
          acc[n] = __builtin_amdgcn_mfma_f32_16x16x32_bf16(wh, ah, acc[n], 0, 0, 0);
          acc[n] = __builtin_amdgcn_mfma_f32_16x16x32_bf16(wl, ah, acc[n], 0, 0, 0);
          acc[n] = __builtin_amdgcn_mfma_f32_16x16x32_bf16(wh, al, acc[n], 0, 0, 0);
        }
      }
      float* part = lgt + 1024 + wid * 768;
#pragma unroll
      for (int n = 0; n < 3; ++n) *(f32x4*)(part + fr * 48 + n * 16 + fq * 4) = acc[n];
    }
    __syncthreads();
    for (int i = tid; i < 768; i += NT) lgt[i] = lgt[1024 + i] + lgt[1024 + 768 + i] + lgt[1024 + 1536 + i] + lgt[1024 + 2304 + i];
    __syncthreads();
    if (tid < 16) {
      const int row = row0 + tid;
      const float* L = lgt + tid * 48;
      float lg[4];
      int gs = 0;
#pragma unroll
      for (int j = 0; j < 4; ++j) lg[j] = L[j] + b_rg[j];
#pragma unroll
      for (int j = 1; j < 4; ++j) if (lg[j] > lg[gs]) gs = j;
      float den = 0.f;
#pragma unroll
      for (int j = 0; j < 4; ++j) den += __expf(lg[j] - lg[gs]);
      const float gw = 1.f / den;
      float le[8];
#pragma unroll
      for (int j = 0; j < 8; ++j) le[j] = L[4 + gs * 8 + j] + b_re[gs * 8 + j];
      int i0 = 0;
#pragma unroll
      for (int j = 1; j < 8; ++j) if (le[j] > le[i0]) i0 = j;
      int i1 = (i0 == 0) ? 1 : 0;
#pragma unroll
      for (int j = 0; j < 8; ++j) if (j != i0 && le[j] > le[i1]) i1 = j;
      const float e1 = __expf(le[i1] - le[i0]);
      const float w0 = gw / (1.f + e1), w1 = gw * e1 / (1.f + e1);
      const int ex0 = gs * 8 + i0, ex1 = gs * 8 + i1;
      const int p0 = atomicAdd(&cnt[ex0], 1);
      list[ex0 * 16384 + p0] = row * 2;
      wts[row * 2] = w0;
      const int p1 = atomicAdd(&cnt[ex1], 1);
      list[ex1 * 16384 + p1] = row * 2 + 1;
      wts[row * 2 + 1] = w1;
    }
    __syncthreads();
  }
}

__device__ __forceinline__ int expert_total(const int* cnt) {
  int acc = 0;
  for (int i = 0; i < 32; ++i) acc += (cnt[i] + 127) >> 7;
  return acc;
}
__device__ __forceinline__ void expert_lookup(const int* cnt, int rbg, int& e, int& rb, int& cnt_e) {
  int acc = 0;
  e = 0; rb = 0; cnt_e = 0;
  for (int i = 0; i < 32; ++i) {
    const int c = cnt[i];
    const int nb = (c + 127) >> 7;
    if (rbg >= acc && rbg < acc + nb) { e = i; rb = rbg - acc; cnt_e = c; }
    acc += nb;
  }
}

__device__ __forceinline__ void phase12(const Params& p, u16* smem) {
  char* ws = p.ws;
  const int* cntg = (const int*)(ws + OFF_CNT);
  const int nrb = expert_total(cntg);
  const int* list = (const int*)(ws + OFF_LIST);
  const u16* x1b = (const u16*)(ws + OFF_X1B);
  const u16* wgt = (const u16*)(ws + OFF_WGT);
  const u16* wut0 = (const u16*)(ws + OFF_WUT0);
  const u16* wut1 = (const u16*)(ws + OFF_WUT1);
  u16* H = (u16*)(ws + OFF_H);
  const int tid = opaque_tid(), lane = tid & 63, wid = tid >> 6;
  const int wr = wid >> 1, wc = wid & 1, fr = lane & 15, fq = lane >> 4;
  const int r = tid >> 3, c = ((tid & 7) ^ ((tid >> 4) & 7)) * 8;
  for (int t = blockIdx.x; t < nrb * 8; t += gridDim.x) {
    const int rbg = t >> 3, hc = t & 7;
    int e, rb, cnt_e;
    expert_lookup(cntg, rbg, e, rb, cnt_e);
    const u16* ap[4];
    const u16* bp[4];
#pragma unroll
    for (int i = 0; i < 4; ++i) {
      const int rr = r + 32 * i;
      const int slot = rb * 128 + rr;
      const int tok = (slot < cnt_e) ? (list[e * 16384 + slot] >> 1) : 0;
      ap[i] = x1b + (size_t)tok * 2048 + c;
      const int sub = rr >> 4, within = rr & 15;
      const int hcol = hc * 64 + (sub >> 1) * 16 + within;
      const u16* ub = (e < 22) ? (wut0 + (size_t)e * 512 * 2048) : (wut1 + (size_t)(e - 22) * 512 * 2048);
      bp[i] = ((sub & 1) ? ub : (wgt + (size_t)e * 512 * 2048)) + (size_t)hcol * 2048 + c;
    }
    f32x4 acc[4][4];
#pragma unroll
    for (int m = 0; m < 4; ++m)
#pragma unroll
      for (int n = 0; n < 4; ++n) acc[m][n] = f32x4{0.f, 0.f, 0.f, 0.f};
    mainloop(smem, ap, bp, 32, acc);
#pragma unroll
    for (int m = 0; m < 4; ++m)
#pragma unroll
      for (int pp = 0; pp < 2; ++pp) {
        const int rowl = wr * 64 + m * 16 + fr;
        const int hcol = hc * 64 + (wc * 2 + pp) * 16 + fq * 4;
        f32x4 o;
#pragma unroll
        for (int j = 0; j < 4; ++j) {
          const float g = acc[m][2 * pp][j], u = acc[m][2 * pp + 1][j];
          o[j] = g * sigmoidf_(g) * u;
        }
        *(uint2*)(H + ((size_t)rbg * 128 + rowl) * 512 + hcol) = pack4(o);
      }
  }
}

__device__ __forceinline__ void phase13(const Params& p, u16* smem) {
  char* ws = p.ws;
  const int* cntg = (const int*)(ws + OFF_CNT);
  const int nrb = expert_total(cntg);
  const int* list = (const int*)(ws + OFF_LIST);
  const float* wts = (const float*)(ws + OFF_WTS);
  const u16* H = (const u16*)(ws + OFF_H);
  const u16* wdt = (const u16*)(ws + OFF_WDT);
  u16* moey = (u16*)(ws + OFF_MOEY);
  const int tid = opaque_tid(), lane = tid & 63, wid = tid >> 6;
  const int wr = wid >> 1, wc = wid & 1, fr = lane & 15, fq = lane >> 4;
  const int r = tid >> 3, c = ((tid & 7) ^ ((tid >> 4) & 7)) * 8;
  for (int t = blockIdx.x; t < nrb * 16; t += gridDim.x) {
    const int rbg = t >> 4, nc = t & 15;
    int e, rb, cnt_e;
    expert_lookup(cntg, rbg, e, rb, cnt_e);
    const u16* ap[4];
    const u16* bp[4];
#pragma unroll
    for (int i = 0; i < 4; ++i) {
      ap[i] = H + ((size_t)rbg * 128 + r + 32 * i) * 512 + c;
      bp[i] = wdt + ((size_t)e * 2048 + nc * 128 + r + 32 * i) * 512 + c;
    }
    f32x4 acc[4][4];
#pragma unroll
    for (int m = 0; m < 4; ++m)
#pragma unroll
      for (int n = 0; n < 4; ++n) acc[m][n] = f32x4{0.f, 0.f, 0.f, 0.f};
    mainloop(smem, ap, bp, 8, acc);
#pragma unroll
    for (int m = 0; m < 4; ++m) {
      const int slot = rb * 128 + wr * 64 + m * 16 + fr;
      if (slot < cnt_e) {
        const int entry = list[e * 16384 + slot];
        const float w = wts[entry];
#pragma unroll
        for (int n = 0; n < 4; ++n) {
          f32x4 o;
#pragma unroll
          for (int j = 0; j < 4; ++j) o[j] = acc[m][n][j] * w;
          *(uint2*)(moey + (size_t)entry * 2048 + nc * 128 + wc * 64 + n * 16 + fq * 4) = pack4(o);
        }
      }
    }
  }
  const u16* x1b = (const u16*)(ws + OFF_X1B);
  const u16* pb = (const u16*)(ws + OFF_PB);
  const u16* wpg = (const u16*)(ws + OFF_WPGT);
  const u16* wple = (const u16*)(ws + OFF_WPLET);
  const float* x1 = (const float*)(ws + OFF_X1);
  float* h2 = p.out;
  bool first = true;
  for (int t = blockIdx.x; t < 128 * 16; t += gridDim.x) {
    int tm, tn;
    tile_map(t, 128, 16, tm, tn);
    const int m0 = tm << 7, n0 = tn << 7;
    const int t2 = t + gridDim.x;
    const bool has_next = t2 < 128 * 16;
    int nm0 = m0, nn0 = n0;
    if (has_next) { int tm2, tn2; tile_map(t2, 128, 16, tm2, tn2); nm0 = tm2 << 7; nn0 = tn2 << 7; }
    const u16* ap[4];
    const u16* bp[4];
    const u16* ap2[4];
    const u16* bp2[4];
    const u16* nap[4];
    const u16* nbp[4];
    f32x4 acc[4][4];
#pragma unroll
    for (int m = 0; m < 4; ++m)
#pragma unroll
      for (int n = 0; n < 4; ++n) acc[m][n] = f32x4{0.f, 0.f, 0.f, 0.f};
#pragma unroll
    for (int i = 0; i < 4; ++i) {
      ap[i] = pb + (size_t)(m0 + r + 32 * i) * 256 + c;
      bp[i] = wple + (size_t)(n0 + r + 32 * i) * 256 + c;
      ap2[i] = x1b + (size_t)(m0 + r + 32 * i) * 2048 + c;
      bp2[i] = wpg + (size_t)(n0 + r + 32 * i) * 2048 + c;
      nap[i] = pb + (size_t)(nm0 + r + 32 * i) * 256 + c;
      nbp[i] = wple + (size_t)(nn0 + r + 32 * i) * 256 + c;
    }
    mainloop_chain(smem, ap, bp, 4, acc, first, true, ap2, bp2);
    first = false;
    uint2 ple[4][4];
#pragma unroll
    for (int m = 0; m < 4; ++m)
#pragma unroll
      for (int n = 0; n < 4; ++n) { ple[m][n] = pack4(acc[m][n]); acc[m][n] = f32x4{0.f, 0.f, 0.f, 0.f}; }
    mainloop_chain(smem, ap2, bp2, 32, acc, false, has_next, nap, nbp);
#pragma unroll
    for (int m = 0; m < 4; ++m)
#pragma unroll
      for (int n = 0; n < 4; ++n) {
        const int row = m0 + wr * 64 + m * 16 + fr, col = n0 + wc * 64 + n * 16 + fq * 4;
        const f32x4 xv = *(const f32x4*)(x1 + (size_t)row * 2048 + col);
        const f32x4 pl = unpack4(ple[m][n]);
        f32x4 o;
#pragma unroll
        for (int j = 0; j < 4; ++j) o[j] = ALPHA_F * xv[j] + sigmoidf_(acc[m][n][j]) * pl[j];
        *(f32x4*)(h2 + (size_t)row * 2048 + col) = o;
      }
  }
}

__device__ __forceinline__ void phase14(const Params& p) {
  char* ws = p.ws;
  float* out = p.out;
  const u16* moey = (const u16*)(ws + OFF_MOEY);
  const float* lnw = p.in[34];
  const float* lnb = p.in[35];
  const int lane = opaque_tid() & 63;
  const int gw = (blockIdx.x * NT + opaque_tid()) >> 6, nw = (gridDim.x * NT) >> 6;
  for (int row0 = gw; row0 < NTOK; row0 += 2 * nw) {
    const int rows[2] = {row0, (row0 + nw < NTOK) ? row0 + nw : row0};
    f32x4 v[2][8];
    float s[2] = {0.f, 0.f};
#pragma unroll
    for (int q = 0; q < 2; ++q) {
      const float* src = out + (size_t)rows[q] * 2048;
#pragma unroll
      for (int i = 0; i < 8; ++i) {
        const int col = i * 256 + lane * 4;
        v[q][i] = *(const f32x4*)(src + col);
        const f32x4 m0 = unpack4(*(const uint2*)(moey + (size_t)(rows[q] * 2) * 2048 + col));
        const f32x4 m1 = unpack4(*(const uint2*)(moey + (size_t)(rows[q] * 2 + 1) * 2048 + col));
#pragma unroll
        for (int j = 0; j < 4; ++j) { v[q][i][j] += m0[j] + m1[j]; s[q] += v[q][i][j]; }
      }
    }
#pragma unroll
    for (int q = 0; q < 2; ++q) {
      const float mean = wave_sum(s[q]) * (1.f / 2048.f);
      float s2 = 0.f;
#pragma unroll
      for (int i = 0; i < 8; ++i)
#pragma unroll
        for (int j = 0; j < 4; ++j) { const float d = v[q][i][j] - mean; s2 += d * d; }
      const float rstd = rsqrtf(wave_sum(s2) * (1.f / 2048.f) + 1e-5f);
      if (q == 1 && rows[1] == rows[0]) continue;
      float* dst = out + (size_t)rows[q] * 2048;
#pragma unroll
      for (int i = 0; i < 8; ++i) {
        const int col = i * 256 + lane * 4;
        const f32x4 w = *(const f32x4*)(lnw + col);
        const f32x4 bb = *(const f32x4*)(lnb + col);
        f32x4 o;
#pragma unroll
        for (int j = 0; j < 4; ++j) o[j] = (v[q][i][j] - mean) * rstd * w[j] + bb[j];
        *(f32x4*)(dst + col) = o;
      }
    }
  }
}


#define XB_TMO      128
#define XB_XCNT(j)  (256  + 64 * (j))
#define XB_XSUB(j)  (1280 + 64 * (j))
#define XB_XGEN(j)  (2304 + 64 * (j))
#define XB_TOP      3328
#define XB_TOPGEN   3392
#define XCD_BAR_WORDS 3456
#define XB_SPIN_CAP (1u << 22)
__device__ __forceinline__ unsigned xb_ld(unsigned* p) { return __hip_atomic_load(p, __ATOMIC_RELAXED, __HIP_MEMORY_SCOPE_AGENT); }
__device__ __forceinline__ unsigned xb_add(unsigned* p, unsigned v) { return __hip_atomic_fetch_add(p, v, __ATOMIC_RELAXED, __HIP_MEMORY_SCOPE_AGENT); }
__device__ __forceinline__ unsigned xb_xcc_id() { return (unsigned)__builtin_amdgcn_s_getreg((3 << 11) | 20) & 0xFu; }
#define XB_SPIN(cond, bar) do { unsigned _sp = 0; while (cond) { __builtin_amdgcn_s_sleep(1); \
    if ((++_sp & 255u) == 0u) { if (xb_ld(&(bar)[XB_TMO])) break; if (_sp > XB_SPIN_CAP) { atomicAdd(&(bar)[XB_TMO], 1u); break; } } } } while (0)
struct XcdBarrier { unsigned* bar; unsigned x, nloc, nx; };
__device__ __forceinline__ void xcd_barrier(const XcdBarrier& b) {
  asm volatile("s_waitcnt vmcnt(0)" ::: "memory");
  __syncthreads();
  if (threadIdx.x == 0) {
    unsigned* bar = b.bar;
    __builtin_amdgcn_s_waitcnt(0);
    const unsigned nloc = b.nloc, nx = b.nx;
    const unsigned old = xb_add(&bar[XB_XSUB(b.x)], 1u);
    const unsigned gen = old / nloc;
    if (old + 1u == (gen + 1u) * nloc) {
      __builtin_amdgcn_fence(__ATOMIC_RELEASE, "agent");
      asm volatile("s_waitcnt vmcnt(0)" ::: "memory");
      const unsigned og = xb_add(&bar[XB_TOP], 1u);
      const unsigned tg = og / nx;
      if (og + 1u == (tg + 1u) * nx) xb_add(&bar[XB_TOPGEN], 1u);
      else XB_SPIN(xb_ld(&bar[XB_TOPGEN]) == tg, bar);
      __builtin_amdgcn_fence(__ATOMIC_ACQUIRE, "agent");
      xb_add(&bar[XB_XGEN(b.x)], 1u);
      asm volatile("s_waitcnt vmcnt(0)" ::: "memory");
    } else {
      XB_SPIN(xb_ld(&bar[XB_XGEN(b.x)]) == gen, bar);
      __builtin_amdgcn_fence(__ATOMIC_ACQUIRE, "agent");
      asm volatile("s_waitcnt vmcnt(0)" ::: "memory");
    }
  }
  __syncthreads();
}

#ifndef LASTP
#define LASTP 14
#endif
__global__ void __launch_bounds__(NT, 2) fwd_megakernel(Params p) {
  __shared__ __attribute__((aligned(16))) u16 smem[32768];
  cg::grid_group grid = cg::this_grid();
  XcdBarrier xb;
  xb.bar = (unsigned*)(p.ws + OFF_BAR);
  xb.x = xb_xcc_id();
  xb.nloc = 1u; xb.nx = 1u;
  if (threadIdx.x == 0) (void)xb_add(&xb.bar[XB_XCNT(xb.x)], 1u);
  phase0(p, (char*)smem);
  if (LASTP < 1) return;
  if (p.out == nullptr) grid.sync();
  __syncthreads();
  if (threadIdx.x == 0) {
    const unsigned G = gridDim.x;
    unsigned sum, cntx, mine, sp = 0u;
    for (;;) {
      sum = 0u; cntx = 0u; mine = 0u;
#pragma unroll
      for (unsigned j = 0; j < 16; ++j) {
        const unsigned c = xb_ld(&xb.bar[XB_XCNT(j)]);
        sum += c; cntx += (c > 0u) ? 1u : 0u; mine = (j == xb.x) ? c : mine;
      }
      if (sum == G) break;
      __builtin_amdgcn_s_sleep(1);
      if (++sp > XB_SPIN_CAP) break;
    }
    ((unsigned*)smem)[0] = mine > 0u ? mine : 1u;
    ((unsigned*)smem)[1] = cntx > 0u ? cntx : 1u;
  }
  __syncthreads();
  xb.nloc = (unsigned)__builtin_amdgcn_readfirstlane((int)((unsigned*)smem)[0]);
  xb.nx = (unsigned)__builtin_amdgcn_readfirstlane((int)((unsigned*)smem)[1]);
  xcd_barrier(xb);
  phase1(p, smem);
  if (LASTP < 2) return;
  xcd_barrier(xb);
  phase2(p, smem);
  if (LASTP < 3) return;
  xcd_barrier(xb);
  phase3(p, smem);
  if (LASTP < 4) return;
  xcd_barrier(xb);
  phase4(p);
  if (LASTP < 5) return;
  xcd_barrier(xb);
  phase5(p, smem);
  if (LASTP < 6) return;
  xcd_barrier(xb);
  phase6(p);
  if (LASTP < 7) return;
  xcd_barrier(xb);
  phase7(p, smem);
  if (LASTP < 8) return;
  xcd_barrier(xb);
  phase8(p);
  if (LASTP < 9) return;
  xcd_barrier(xb);
  phase9(p, smem);
  if (LASTP < 10) return;
  xcd_barrier(xb);
  phase10(p, smem);
  if (LASTP < 11) return;
  xcd_barrier(xb);
  phase11(p, smem);
  if (LASTP < 12) return;
  xcd_barrier(xb);
  phase12(p, smem);
  if (LASTP < 13) return;
  xcd_barrier(xb);
  phase13(p, smem);
  if (LASTP < 14) return;
  xcd_barrier(xb);
  phase14(p);
}

extern "C" void kernel_launch(void* const* d_in, const int* in_sizes, int n_in, void* d_out, int out_size, void* d_ws,
                              size_t ws_size, hipStream_t stream) {
  static int grid_blocks = 0;
  if (!grid_blocks) {
    int dev = 0, cus = 0, per_cu = 0;
    hipGetDevice(&dev);
    hipDeviceGetAttribute(&cus, hipDeviceAttributeMultiprocessorCount, dev);
    hipOccupancyMaxActiveBlocksPerMultiprocessor(&per_cu, fwd_megakernel, NT, 0);
    if (per_cu > 2) per_cu = 2;
    grid_blocks = cus * per_cu;
  }
  if (ws_size < WS_NEED || n_in < 36) {
    fprintf(stderr, "workspace too small: %zu < %zu\n", ws_size, (size_t)WS_NEED);
    return;
  }
  Params p{};
  for (int i = 0; i < 36; ++i) p.in[i] = (const float*)d_in[i];
  p.out = (float*)d_out;
  p.ws = (char*)d_ws;
  (void)hipMemsetAsync((char*)d_ws + OFF_BAR, 0, 16384, stream);
  void* args[] = {&p};
  hipError_t e = hipLaunchCooperativeKernel((void*)fwd_megakernel, dim3(grid_blocks), dim3(NT), args, 0, stream);
  if (e != hipSuccess) fprintf(stderr, "cooperative launch failed: %s (grid %d)\n", hipGetErrorString(e), grid_blocks);
}
```
